# Optimizing an MI355X kernel written in HIP

```python
import jax, jax.numpy as jnp
from jax import lax
import numpy as np

D_MODEL = 1024
BATCH = 2
SEQ = 8192
DEPTH = 2

MIX_WIDTH = D_MODEL
ATTN_WIDTH = MIX_WIDTH // 2
HGRN_WIDTH = MIX_WIDTH - ATTN_WIDTH
HEAD_DIM = 64
N_ATTN_HEADS = ATTN_WIDTH // HEAD_DIM
HGRN_EXPAND = 64
N_HGRN_HEADS = HGRN_WIDTH // HGRN_EXPAND
HGRN_VDIM = HGRN_WIDTH // N_HGRN_HEADS
DILATED_PATTERNS = ((128, 1), (512, 4), (2048, 16))
ATTN_BLOCK = 128
HGRN_CHUNK = 64
ROPE_THETA = 10000.0
N_EXPERTS = 16
N_GROUPS = 4
EXPERTS_PER_GROUP = N_EXPERTS // N_GROUPS
TOP_K = 2
D_FF_EXPERT = 512
RMS_EPS = 1e-6
IN_COLS = 3 * ATTN_WIDTH + 4 * HGRN_WIDTH

kernel_name = 'hybrid_dilated_attn_hgrn2_grouped_moe_adaln'


def rms_norm(x, gain=None):
    xf = x.astype(jnp.float32)
    y = xf * lax.rsqrt(jnp.mean(xf * xf, axis=-1, keepdims=True) + RMS_EPS)
    if gain is not None:
        y = y * gain.astype(jnp.float32)
    return y


def rotary(t, positions):
    half = HEAD_DIM // 2
    inv_freq = ROPE_THETA ** (-jnp.arange(half, dtype=jnp.float32) / half)
    ang = positions.astype(jnp.float32)[:, None, :, None] * inv_freq
    cos, sin = jnp.cos(ang), jnp.sin(ang)
    t1, t2 = t[..., :half], t[..., half:]
    return jnp.concatenate([t1 * cos - t2 * sin, t1 * sin + t2 * cos], axis=-1)


def dilated_window_pattern(q, k, v, window, dilation):
    B, H, S, Dh = q.shape
    steps = window // dilation
    span = dilation * ATTN_BLOCK
    s_pad = -(-S // span) * span
    m = s_pad // dilation
    nb = m // ATTN_BLOCK

    def to_streams(t):
        t = jnp.pad(t, ((0, 0), (0, 0), (0, s_pad - S), (0, 0)))
        t = t.reshape(B, H, m, dilation, Dh).transpose(0, 1, 3, 2, 4)
        return t.reshape(B, H, dilation, nb, ATTN_BLOCK, Dh)

    qs, ks, vs = to_streams(q), to_streams(k), to_streams(v)

    def with_prev(t):
        prev = jnp.pad(t, ((0, 0), (0, 0), (0, 0), (1, 0), (0, 0), (0, 0)))[:, :, :, :-1]
        return jnp.concatenate([prev, t], axis=-2)

    kk, vv = with_prev(ks), with_prev(vs)
    scores = jnp.einsum('bhrnqd,bhrnkd->bhrnqk', qs, kk) * (HEAD_DIM ** -0.5)
    qi = jnp.arange(ATTN_BLOCK)[:, None]
    kj = jnp.arange(2 * ATTN_BLOCK)[None, :]
    dist = qi + ATTN_BLOCK - kj
    in_band = (dist >= 0) & (dist <= steps)
    first_block = (jnp.arange(nb) == 0)[:, None, None]
    valid = in_band[None] & ~(first_block & (kj < ATTN_BLOCK)[None])
    scores = jnp.where(valid, scores, -jnp.inf)
    mx = jnp.max(scores, axis=-1, keepdims=True)
    p = jnp.exp(scores - mx)
    den = jnp.sum(p, axis=-1, keepdims=True)
    out = jnp.einsum('bhrnqk,bhrnkd->bhrnqd', p, vv) / den

    def from_streams(t):
        X = t.shape[-1]
        t = t.reshape(B, H, dilation, m, X).transpose(0, 1, 3, 2, 4).reshape(B, H, s_pad, X)
        return t[:, :, :S]

    return from_streams(out), from_streams(mx), from_streams(den)


def dilated_mixture_attention(q, k, v):
    results = [dilated_window_pattern(q, k, v, w, d) for (w, d) in DILATED_PATTERNS]
    out = jnp.stack([r[0] for r in results])
    mx = jnp.stack([r[1] for r in results])
    den = jnp.stack([r[2] for r in results])
    weight = den * jnp.exp(mx - jnp.max(mx, axis=0, keepdims=True))
    return jnp.sum(weight * out, axis=0) / jnp.sum(weight, axis=0)


def hgrn2_mixer(q, f_raw, i, lower_bound):
    B, S, _ = q.shape
    C = HGRN_CHUNK
    nc = S // C
    q = jax.nn.silu(q)
    f = lower_bound + (1.0 - lower_bound) * jax.nn.sigmoid(f_raw)
    log_f = jnp.log(f)
    key = 1.0 - f

    def to_chunks(t, dim):
        return t.reshape(B, nc, C, N_HGRN_HEADS, dim).transpose(1, 0, 3, 2, 4)

    qc = to_chunks(q, HGRN_EXPAND)
    kc = to_chunks(key, HGRN_EXPAND)
    gc = to_chunks(log_f, HGRN_EXPAND)
    vc = to_chunks(i, HGRN_VDIM)
    causal = jnp.tril(jnp.ones((C, C), dtype=bool))[:, :, None]

    def chunk_step(state, inp):
        q_, k_, g_, v_ = inp
        b = jnp.cumsum(g_, axis=-2)
        o_inter = jnp.einsum('bhtk,bhkv->bhtv', q_ * jnp.exp(b), state)
        diff = b[:, :, :, None, :] - b[:, :, None, :, :]
        decay = jnp.where(causal, jnp.exp(jnp.where(causal, diff, 0.0)), 0.0)
        scores = jnp.einsum('bhtk,bhsk,bhtsk->bhts', q_, k_, decay)
        o_intra = jnp.einsum('bhts,bhsv->bhtv', scores, v_)
        b_last = b[:, :, -1:, :]
        new_state = jnp.exp(b_last)[:, :, 0, :, None] * state + jnp.einsum(
            'bhsk,bhsv->bhkv', k_ * jnp.exp(b_last - b), v_)
        return new_state, o_inter + o_intra

    state0 = jnp.zeros((B, N_HGRN_HEADS, HGRN_EXPAND, HGRN_VDIM), jnp.float32)
    _, o = lax.scan(chunk_step, state0, (qc, kc, gc, vc))
    return o.transpose(1, 0, 3, 2, 4).reshape(B, S, HGRN_WIDTH)


def mixing_sublayer(h, positions, w_in, w_out, attn_norm, hgrn_norm, lower_bound):
    B, S, _ = h.shape
    proj = jnp.einsum('bsd,de->bse', h, w_in).astype(jnp.float32)
    cuts = np.cumsum([ATTN_WIDTH] * 3 + [HGRN_WIDTH] * 3).tolist()
    q_a, k_a, v_a, q_h, f_h, i_h, g_h = jnp.split(proj, cuts, axis=-1)

    def heads(t):
        return t.reshape(B, S, N_ATTN_HEADS, HEAD_DIM).transpose(0, 2, 1, 3)

    q_a = rotary(heads(q_a), positions)
    k_a = rotary(heads(k_a), positions)
    attn = dilated_mixture_attention(q_a, k_a, heads(v_a))
    attn = attn.transpose(0, 2, 1, 3).reshape(B, S, ATTN_WIDTH)
    rec = hgrn2_mixer(q_h, f_h, i_h, lower_bound)
    rec = rms_norm(rec, hgrn_norm) * jax.nn.sigmoid(g_h)
    merged = jnp.concatenate([rms_norm(attn, attn_norm), rec], axis=-1)
    return jnp.einsum('bse,ed->bsd', merged.astype(w_out.dtype), w_out)


def grouped_moe(h, w_router, b_router, w_gate, w_up, w_down):
    B, S, D = h.shape
    T = B * S
    hf = h.reshape(T, D)
    logits = (hf @ w_router).astype(jnp.float32) + b_router.astype(jnp.float32)
    probs = jax.nn.softmax(logits, axis=-1)
    pg = probs.reshape(T, N_GROUPS, EXPERTS_PER_GROUP)
    top_in_group, _ = lax.top_k(pg, TOP_K)
    g_sel = jnp.argmax(jnp.sum(top_in_group, axis=-1), axis=-1)
    in_group = jnp.einsum('tg,tge->te', jax.nn.one_hot(g_sel, N_GROUPS, dtype=jnp.float32), pg)
    vals, idx = lax.top_k(in_group, TOP_K)
    wts = vals / jnp.sum(vals, axis=-1, keepdims=True)
    expert_idx = g_sel[:, None] * EXPERTS_PER_GROUP + idx
    combine = jnp.einsum('tke,tk->te', jax.nn.one_hot(expert_idx, N_EXPERTS, dtype=jnp.float32), wts)
    y = jnp.zeros((T, D), jnp.float32)
    for e in range(N_EXPERTS):
        a = jax.nn.silu(hf @ w_gate[e]) * (hf @ w_up[e])
        y = y + combine[:, e:e + 1] * (a @ w_down[e]).astype(jnp.float32)
    return y.reshape(B, S, D)


def setup_inputs(seed: int = 0) -> dict:
    key = jax.random.key(seed)
    ks = jax.random.split(key, 16)
    D, E, F = D_MODEL, N_EXPERTS, D_FF_EXPERT
    offsets = jax.random.randint(ks[2], (BATCH, 1), 0, 1024, dtype=jnp.int32)
    positions = (offsets + jnp.arange(SEQ, dtype=jnp.int32)[None, :]).astype(jnp.int32)
    return {
        'x': jax.random.normal(ks[0], (BATCH, SEQ, D), jnp.float32),
        'c': jax.random.normal(ks[1], (BATCH, D), jnp.float32),
        'positions': positions,
        'w_in': jax.random.normal(ks[3], (DEPTH, D, IN_COLS), jnp.float32) * D ** -0.5,
        'w_out': jax.random.normal(ks[4], (DEPTH, MIX_WIDTH, D), jnp.float32) * MIX_WIDTH ** -0.5,
        'attn_norm': 1.0 + 0.05 * jax.random.normal(ks[5], (DEPTH, ATTN_WIDTH), jnp.float32),
        'hgrn_norm': 1.0 + 0.05 * jax.random.normal(ks[6], (DEPTH, HGRN_WIDTH), jnp.float32),
        'lb_params': 0.5 * jax.random.normal(ks[7], (DEPTH, HGRN_WIDTH), jnp.float32),
        'ada_w': jax.random.normal(ks[8], (DEPTH, D, 6 * D), jnp.float32) * (0.5 * D ** -0.5),
        'ada_b': 0.02 * jax.random.normal(ks[9], (DEPTH, 6 * D), jnp.float32),
        'w_router': jax.random.normal(ks[10], (D, E), jnp.float32) * D ** -0.5,
        'b_router': 0.01 * jax.random.normal(ks[11], (E,), jnp.float32),
        'w_gate': jax.random.normal(ks[12], (DEPTH, E, D, F), jnp.float32) * D ** -0.5,
        'w_up': jax.random.normal(ks[13], (DEPTH, E, D, F), jnp.float32) * D ** -0.5,
        'w_down': jax.random.normal(ks[14], (DEPTH, E, F, D), jnp.float32) * F ** -0.5,
        'final_norm': 1.0 + 0.05 * jax.random.normal(ks[15], (D,), jnp.float32),
    }


def reference(x, c, positions, w_in, w_out, attn_norm, hgrn_norm, lb_params, ada_w, ada_b,
              w_router, b_router, w_gate, w_up, w_down, final_norm):
    p = jax.nn.softmax(lb_params.astype(jnp.float32), axis=0)
    lower_bounds = jnp.cumsum(p, axis=0) - p[0:1]
    c_act = jax.nn.silu(c)
    for l in range(DEPTH):
        mod = (jnp.einsum('bd,de->be', c_act, ada_w[l]) + ada_b[l]).astype(jnp.float32)
        sh1, sc1, g1, sh2, sc2, g2 = jnp.split(mod[:, None, :], 6, axis=-1)
        h = (rms_norm(x) * (1.0 + sc1) + sh1).astype(x.dtype)
        mix = mixing_sublayer(h, positions, w_in[l], w_out[l], attn_norm[l], hgrn_norm[l],
                              lower_bounds[l])
        x = x + (g1 * mix.astype(jnp.float32)).astype(x.dtype)
        h = (rms_norm(x) * (1.0 + sc2) + sh2).astype(x.dtype)
        ffn = grouped_moe(h, w_router, b_router, w_gate[l], w_up[l], w_down[l])
        x = x + (g2 * ffn).astype(x.dtype)
    return rms_norm(x, final_norm).astype(x.dtype)
```

```cpp
#define MK_ONE_LAUNCH 1
#define WT_STORES 0
#define NT_ONCE 1
#define CNT_CACHE 1
#define EARLY_ACQ 1
#define HG_WIDE 1
#define PRO_POLISH 1
#define Y_FP8 1
#define BR_FP8 3
#define OUT16 1
#define OG_U8 1
#include <hip/hip_runtime.h>
#include <cstdio>
#include <cstdint>
namespace mk {
#define LAS __attribute__((address_space(3)))
#define GAS __attribute__((address_space(1)))
typedef unsigned short bf16_t;
typedef short bf16x8 __attribute__((ext_vector_type(8)));
typedef short s16x4 __attribute__((ext_vector_type(4)));
typedef float f32x2 __attribute__((ext_vector_type(2)));
typedef float f32x4 __attribute__((ext_vector_type(4)));
typedef float f32x16 __attribute__((ext_vector_type(16)));
typedef unsigned u32x2 __attribute__((ext_vector_type(2)));
typedef unsigned u32x4 __attribute__((ext_vector_type(4)));
typedef unsigned gu32;

constexpr int D = 1024, NB = 2, S = 8192, T = NB * S, DEPTH = 2, AW = 512, HW = 512, HD = 64, NH = 8, INC = 3584, NE = 16, FF = 512;
constexpr float EPS = 1e-6f;
constexpr float LOG2E = 1.4426950408889634f;
constexpr float QSCALE = 0.125f * LOG2E;
constexpr int NWAVES = 8, NTHR = 512;

constexpr size_t MiB = 1u << 20;
#if defined(PRO_POLISH) && PRO_POLISH
constexpr size_t WS_CTL = 0, CTL_BYTES = 192 * 1024;
#else
constexpr size_t WS_CTL = 0, CTL_BYTES = 1 * MiB;
#endif
constexpr size_t WS_ROPE_C = 1 * MiB, WS_ROPE_S = 3 * MiB;
constexpr size_t WS_LIST = 5 * MiB, WS_PW = 6 * MiB;
constexpr size_t WS_CNTB = 8 * MiB + 512 * 1024, WS_SELG = 8 * MiB + 576 * 1024;
constexpr size_t WS_LSE = 7 * MiB;
constexpr size_t WS_DEC = 9 * MiB;
constexpr size_t WS_WIN = 10 * MiB, WS_WOUT = 17 * MiB, WS_WGU = 19 * MiB, WS_WD = 51 * MiB;
constexpr size_t WS_HB = 68 * MiB;
constexpr size_t WS_QA = 100 * MiB, WS_KA = 116 * MiB, WS_VA = 132 * MiB, WS_QH = 148 * MiB, WS_IH = 164 * MiB, WS_OG = 180 * MiB;
constexpr size_t WS_GH = 196 * MiB;
constexpr size_t WS_ADAP = 228 * MiB;
constexpr size_t WS_PART = 228 * MiB;
constexpr size_t WS_REC = 276 * MiB;
constexpr size_t WS_SLOC = 292 * MiB;
constexpr size_t WS_XB = 308 * MiB;
constexpr size_t WS_MH = 100 * MiB;
constexpr size_t WS_Y = 134 * MiB;
constexpr size_t WS_END = 340 * MiB;
static_assert(WS_MH + (size_t)(2 * T + 256) * FF * 2 <= WS_Y && WS_Y + (size_t)2 * T * D * 2 <= WS_PART, "ws overlay map");

constexpr int CW_BAR = 1024;
constexpr int CW_CNT = 8192;
#if defined(PRO_POLISH) && PRO_POLISH
constexpr int CW_RDY = 16384, CW_TMO = 12288, CW_MOD = 49152;
#else
constexpr int CW_RDY = 65536;
constexpr int CW_TMO = 200000;
constexpr int CW_MOD = 16384;
#endif
constexpr int CW_ADAP = 65536;

__device__ __forceinline__ int lane_id_asm2() { int l; asm volatile("v_mbcnt_lo_u32_b32 %0, -1, 0\n\tv_mbcnt_hi_u32_b32 %0, -1, %0" : "=v"(l)); return l; }
__device__ __forceinline__ float wave_sum(float v) {
    v += __builtin_bit_cast(float, __builtin_amdgcn_update_dpp(0, __builtin_bit_cast(int, v), 0xB1, 0xF, 0xF, false));
    v += __builtin_bit_cast(float, __builtin_amdgcn_update_dpp(0, __builtin_bit_cast(int, v), 0x4E, 0xF, 0xF, false));
    v += __builtin_bit_cast(float, __builtin_amdgcn_update_dpp(0, __builtin_bit_cast(int, v), 0x141, 0xF, 0xF, false));
    v += __builtin_bit_cast(float, __builtin_amdgcn_update_dpp(0, __builtin_bit_cast(int, v), 0x140, 0xF, 0xF, false));
    v += __builtin_bit_cast(float, __builtin_amdgcn_update_dpp(0, __builtin_bit_cast(int, v), 0x142, 0xA, 0xF, false));
    v += __builtin_bit_cast(float, __builtin_amdgcn_update_dpp(0, __builtin_bit_cast(int, v), 0x143, 0xC, 0xF, false));
    return __builtin_bit_cast(float, __builtin_amdgcn_readlane(__builtin_bit_cast(int, v), 63));
}
__device__ __forceinline__ float xhalf_max(float x) { const int l = lane_id_asm2(); return fmaxf(x, __builtin_bit_cast(float, __builtin_amdgcn_ds_bpermute((l ^ 32) << 2, __builtin_bit_cast(int, x)))); }
__device__ __forceinline__ float xhalf_sum(float x) { const int l = lane_id_asm2(); return x + __builtin_bit_cast(float, __builtin_amdgcn_ds_bpermute((l ^ 32) << 2, __builtin_bit_cast(int, x))); }
__device__ __forceinline__ unsigned f2bf(float f) { unsigned u = __builtin_bit_cast(unsigned, f); return (u + 0x7fffu + ((u >> 16) & 1u)) >> 16; }
typedef __bf16 bf16x2_t __attribute__((ext_vector_type(2)));
#if defined(HW_PK2) && HW_PK2
__device__ __forceinline__ unsigned pk2(float lo, float hi) { f32x2 v = {lo, hi}; bf16x2_t b = __builtin_convertvector(v, bf16x2_t); return __builtin_bit_cast(unsigned, b); }
#else
__device__ __forceinline__ unsigned pk2(float lo, float hi) { return f2bf(lo) | (f2bf(hi) << 16); }
#endif
__device__ __forceinline__ float bf2f(unsigned short b) { return __builtin_bit_cast(float, ((unsigned)b) << 16); }
__device__ __forceinline__ float bflo(unsigned w) { return __builtin_bit_cast(float, w << 16); }
__device__ __forceinline__ float bfhi(unsigned w) { return __builtin_bit_cast(float, w & 0xffff0000u); }
__device__ __forceinline__ float silu_f(float x) { return x * __builtin_amdgcn_rcpf(1.f + __expf(-x)); }
__device__ __forceinline__ float sigm_f(float x) { return __builtin_amdgcn_rcpf(1.f + __expf(-x)); }
template <class Tp> __device__ __forceinline__ Tp* opq(Tp* p) { asm volatile("" : "+s"(p)); return p; }
__device__ __forceinline__ int opqv(int v) { asm volatile("" : "+v"(v)); return v; }
__device__ __forceinline__ int opqs(int v) { asm volatile("" : "+s"(v)); return v; }
__device__ __forceinline__ int lane_id_asm() { int l; asm volatile("v_mbcnt_lo_u32_b32 %0, -1, 0\n\tv_mbcnt_hi_u32_b32 %0, -1, %0" : "=v"(l)); return l; }
#if defined(NT_ONCE) && NT_ONCE
#define NT_LOAD(p) __builtin_nontemporal_load(p)
#else
#define NT_LOAD(p) (*(p))
#endif
#define F8SAT(x) __builtin_amdgcn_fmed3f((x), -448.0f, 448.0f)
#define LDS_WAIT() asm volatile("s_waitcnt lgkmcnt(0)" ::: "memory")
#define VM_WAIT() asm volatile("s_waitcnt vmcnt(0)" ::: "memory")

#define XB_TMO      128
#define XB_XCNT(j)  (256  + 64 * (j))
#define XB_XSUB(j)  (1280 + 64 * (j))
#define XB_XGEN(j)  (2304 + 64 * (j))
#define XB_TOP      3328
#define XB_TOPGEN   3392
#define XCD_BAR_WORDS 3456
#define XB_SPIN_CAP (1u << 18)
__device__ __forceinline__ unsigned xb_ld(unsigned* p)              { return __hip_atomic_load(p, __ATOMIC_RELAXED, __HIP_MEMORY_SCOPE_AGENT); }
__device__ __forceinline__ unsigned xb_add(unsigned* p, unsigned v) { return __hip_atomic_fetch_add(p, v, __ATOMIC_RELAXED, __HIP_MEMORY_SCOPE_AGENT); }
__device__ __forceinline__ unsigned xb_xcc_id() { return (unsigned)__builtin_amdgcn_s_getreg((3 << 11) | 20) & 0xFu; }
#define XB_SPIN(cond, bar) do { unsigned _sp = 0; while (cond) { __builtin_amdgcn_s_sleep(1); \
    if ((++_sp & 255u) == 0u) { if (xb_ld(&(bar)[XB_TMO])) break; if (_sp > XB_SPIN_CAP) { atomicAdd(&(bar)[XB_TMO], 1u); break; } } } } while (0)
struct XcdBarrier { unsigned* bar; unsigned x; volatile LAS unsigned* st; };
__device__ __forceinline__ XcdBarrier xcd_barrier_post(unsigned* bar, volatile LAS unsigned* st) {
    XcdBarrier b; b.bar = bar; b.x = xb_xcc_id(); b.st = st;
    if (threadIdx.x == 0) (void)xb_add(&bar[XB_XCNT(b.x)], 1u);
    return b;
}
__device__ __forceinline__ void xcd_barrier_complete(unsigned* bar, unsigned x, unsigned& nloc, unsigned& nx) {
    const unsigned G = gridDim.x * gridDim.y * gridDim.z;
    unsigned sum, cnt, mine, sp = 0u;
    for (;;) {
        sum = 0u; cnt = 0u; mine = 0u;
#pragma unroll
        for (unsigned j = 0; j < 16; ++j) { const unsigned c = xb_ld(&bar[XB_XCNT(j)]); sum += c; cnt += (c > 0u) ? 1u : 0u; mine = (j == x) ? c : mine; }
        if (sum == G) break;
        __builtin_amdgcn_s_sleep(1);
        if ((++sp & 255u) == 0u) { if (xb_ld(&bar[XB_TMO])) break; if (sp > XB_SPIN_CAP) { atomicAdd(&bar[XB_TMO], 1u); break; } }
    }
    nloc = mine > 0u ? mine : 1u; nx = cnt > 0u ? cnt : 1u;
}
__device__ __forceinline__ void xcd_barrier(const XcdBarrier& b) {
    asm volatile("s_waitcnt vmcnt(0)" ::: "memory");
    __syncthreads();
    if (threadIdx.x == 0) {
        unsigned* bar = b.bar;
        __builtin_amdgcn_s_waitcnt(0);
        unsigned nloc = b.st[0], nx = b.st[1];
        if (nloc == 0u) { xcd_barrier_complete(bar, b.x, nloc, nx); b.st[0] = nloc; b.st[1] = nx; }
        const unsigned old = xb_add(&bar[XB_XSUB(b.x)], 1u);
        const unsigned gen = old / nloc;
        if (old + 1u == (gen + 1u) * nloc) {
            __builtin_amdgcn_fence(__ATOMIC_RELEASE, "agent");
            asm volatile("s_waitcnt vmcnt(0)" ::: "memory");
            const unsigned og = xb_add(&bar[XB_TOP], 1u);
            const unsigned tg = og / nx;
            if (og + 1u == (tg + 1u) * nx) xb_add(&bar[XB_TOPGEN], 1u);
            else XB_SPIN(xb_ld(&bar[XB_TOPGEN]) == tg, bar);
            __builtin_amdgcn_fence(__ATOMIC_ACQUIRE, "agent");
            xb_add(&bar[XB_XGEN(b.x)], 1u);
            asm volatile("s_waitcnt vmcnt(0)" ::: "memory");
        } else {
            XB_SPIN(xb_ld(&bar[XB_XGEN(b.x)]) == gen, bar);
            __builtin_amdgcn_fence(__ATOMIC_ACQUIRE, "agent");
            asm volatile("s_waitcnt vmcnt(0)" ::: "memory");
        }
    }
    __syncthreads();
}

constexpr int BM = 256, BK = 64, HALF = 128, HTB = HALF * BK * 2, STAGE_BYTES = 8 * HTB;
__host__ __device__ __forceinline__ int lds_byte(int r, int c) { const int st = (r >> 4) * 2 + (c >> 5), rr = r & 15, cc = c & 31, ob = rr * 64 + cc * 2; return st * 1024 + (ob ^ (((ob >> 9) & 1) << 5)); }
__host__ __device__ __forceinline__ void stage_rc(int b, int& R, int& C) { const int st = b / 1024, sb = b % 1024, swz = sb ^ (((sb >> 9) & 1) << 5); R = (st >> 1) * 16 + swz / 64; C = (st & 1) * 32 + (swz % 64) / 2; }
__host__ __device__ __forceinline__ int perm32(int rho) { const int n = rho >> 4, i = rho & 15; return 8 * (i >> 2) + 4 * n + (i & 3); }
__device__ __forceinline__ unsigned cvt_pk_bf16(float lo, float hi) { f32x2 v = {lo, hi}; bf16x2_t b = __builtin_convertvector(v, bf16x2_t); return __builtin_bit_cast(unsigned, b); }
__device__ __forceinline__ unsigned cvt1_bf16(float x) { return cvt_pk_bf16(x, 0.f) & 0xffffu; }

struct GUnit { const char* A; const char* B; int pm, pn; int e, row0, nrows, rtg; };

template <class Epi, class Sched, bool GATHER>
__device__ __forceinline__ void gemm_phase(LAS unsigned char* lds, const int K, const Sched& S, const Epi& E, const int tid) {
    const int wid = __builtin_amdgcn_readfirstlane(tid >> 6), lane = tid & 63, wr = wid >> 2, wc = wid & 3, fr = lane & 15, fq = lane >> 4;
    const int nt = K / BK;
    unsigned voffB[2];
#pragma unroll
    for (int i = 0; i < 2; ++i) { int R_, C_; stage_rc(tid * 16 + i * 8192, R_, C_);
        const int Rb = Epi::PERM16 ? (64 * (R_ >> 5) + 16 * ((R_ & 15) >> 2) + 4 * ((R_ & 31) >> 4) + (R_ & 3)) : Epi::PERM ? ((R_ & ~31) + perm32(R_ & 31)) : R_;
        voffB[i] = (unsigned)(Rb * K + C_) * 2u; }
#define PG8_VOA(dst, unit) do { _Pragma("unroll") for (int h_ = 0; h_ < 2; ++h_) _Pragma("unroll") for (int i_ = 0; i_ < 2; ++i_) { int R_, C_; stage_rc(tid * 16 + i_ * 8192, R_, C_); \
        dst[h_][i_] = GATHER ? (unsigned)S.arow(unit, h_ * HALF + R_) * (unsigned)(K * 2) + (unsigned)C_ * 2u : (unsigned)((h_ * HALF + R_) * K + C_) * 2u; } } while (0)
    const size_t kstep = (size_t)(BK * 2);
    const size_t hstep = Epi::PERM16 ? (size_t)8 * K * 2 : (size_t)HALF * K * 2;
    const unsigned ldsw = (unsigned)wid * 1024u;
    const int aoff = lds_byte(wr * 64 + fr, fq * 8), boff = lds_byte(wc * 32 + fr, fq * 8);
#define PG8_SA(b, h) (((b) * 2 + (h)) * HTB)
#define PG8_SB(b, h) ((4 + (b) * 2 + (h)) * HTB)
#define PG8_STAGE(bufoff, gbase, voff) do { _Pragma("unroll") for (int _i = 0; _i < 2; ++_i) \
        __builtin_amdgcn_global_load_lds((const unsigned*)((const char*)(gbase) + (voff)[_i]), (LAS unsigned*)(lds + (bufoff) + ldsw + _i * 8192), 16, 0, 0); } while (0)
#define PG8_LDA(dst, b, h) do { _Pragma("unroll") for (int m = 0; m < 4; ++m) _Pragma("unroll") for (int k = 0; k < 2; ++k) dst[m][k] = *(const LAS bf16x8*)(lds + PG8_SA(b, h) + aoff + m * 2048 + k * 1024); } while (0)
#define PG8_LDB(dst, b, h) do { _Pragma("unroll") for (int n = 0; n < 2; ++n) _Pragma("unroll") for (int k = 0; k < 2; ++k) dst[n][k] = *(const LAS bf16x8*)(lds + PG8_SB(b, h) + boff + n * 2048 + k * 1024); } while (0)
#define PG8_MMA(ai, bj, At, Bt) do { __builtin_amdgcn_s_setprio(1); _Pragma("unroll") for (int m = 0; m < 4; ++m) _Pragma("unroll") for (int n = 0; n < 2; ++n) _Pragma("unroll") for (int k = 0; k < 2; ++k) \
        acc[ai][bj][m][n] = __builtin_amdgcn_mfma_f32_16x16x32_bf16(Bt[n][k], At[m][k], acc[ai][bj][m][n], 0, 0, 0); __builtin_amdgcn_s_setprio(0); } while (0)
#define PG8_WAIT_V(n) asm volatile("s_waitcnt vmcnt(" #n ")" ::: "memory")
#define PG8_WAIT_L(n) asm volatile("s_waitcnt lgkmcnt(" #n ")" ::: "memory")
#define PG8_BAR __builtin_amdgcn_s_barrier()
#define PG8_SCHED __builtin_amdgcn_sched_barrier(0)
    GUnit cur, nxt; int ui = 0;
    if (!S.next(0, cur)) return;
    typename Sched::Early est; S.early_reset(est);
    unsigned voA[2][2], voN[2][2];
    PG8_VOA(voA, cur);
    float z0 = 0.f; asm volatile("" : "+v"(z0));
    f32x4 acc[2][2][4][2];
#pragma unroll
    for (int a = 0; a < 2; ++a)
#pragma unroll
        for (int b = 0; b < 2; ++b)
#pragma unroll
            for (int m = 0; m < 4; ++m)
#pragma unroll
                for (int n = 0; n < 2; ++n) acc[a][b][m][n] = (f32x4){z0, z0, z0, z0};
    bf16x8 At[4][2], B0[2][2], B1[2][2];
    const char* cA = cur.A; const char* cB = cur.B;
    S.a_ready(cur, 0, est);
    PG8_STAGE(PG8_SB(0, 0), cB, voffB); PG8_STAGE(PG8_SB(0, 1), cB + hstep, voffB); PG8_STAGE(PG8_SA(0, 0), cA, voA[0]); PG8_STAGE(PG8_SA(0, 1), cA, voA[1]);
    if (wr == 1) PG8_BAR;
    PG8_WAIT_V(2); PG8_BAR;
    PG8_STAGE(PG8_SB(1, 0), cB + kstep, voffB); PG8_STAGE(PG8_SA(1, 0), cA + kstep, voA[0]); PG8_STAGE(PG8_SB(1, 1), cB + hstep + kstep, voffB);
    PG8_WAIT_V(6); PG8_BAR;
    for (;;) {
        const bool has_next = S.next(ui + 1, nxt);
        const char* nA = has_next ? nxt.A : cA; const char* nB = has_next ? nxt.B : cB;
        for (int t = 0; t < nt; t += 2) {
            const bool last = (t == nt - 2);
            if (last && has_next) S.a_ready(nxt, ui + 1, est);
            if (Sched::mode == 1 && !last && has_next) S.a_early(nxt, est);
            if (GATHER && last) {
                if (has_next) PG8_VOA(voN, nxt);
                else {
#pragma unroll
                    for (int h = 0; h < 2; ++h)
#pragma unroll
                        for (int i = 0; i < 2; ++i) voN[h][i] = voA[h][i];
                }
            }
            const char* a1 = cA + (size_t)(t + 1) * kstep;
            const char* a2 = last ? nA : cA + (size_t)(t + 2) * kstep; const char* b2 = last ? nB : cB + (size_t)(t + 2) * kstep;
            const char* a3 = a2 + kstep; const char* b3 = b2 + kstep;
            unsigned v2[2][2];
#pragma unroll
            for (int h = 0; h < 2; ++h)
#pragma unroll
                for (int i = 0; i < 2; ++i) v2[h][i] = (GATHER && last) ? voN[h][i] : voA[h][i];
            PG8_LDB(B0, 0, 0); PG8_LDB(B1, 0, 1); PG8_SCHED; PG8_LDA(At, 0, 0); PG8_STAGE(PG8_SA(1, 1), a1, voA[1]);
            PG8_WAIT_V(8); PG8_WAIT_L(0); PG8_BAR; PG8_MMA(0, 0, At, B0); PG8_MMA(0, 1, At, B1); PG8_BAR; PG8_SCHED;
            PG8_LDA(At, 0, 1); PG8_STAGE(PG8_SB(0, 0), b2, voffB); PG8_STAGE(PG8_SB(0, 1), b2 + hstep, voffB); PG8_STAGE(PG8_SA(0, 0), a2, v2[0]);
            PG8_WAIT_V(8); PG8_WAIT_L(0); PG8_BAR; PG8_MMA(1, 0, At, B0); PG8_MMA(1, 1, At, B1); PG8_BAR; PG8_SCHED;
            PG8_LDB(B0, 1, 0); PG8_LDB(B1, 1, 1); PG8_SCHED; PG8_LDA(At, 1, 0); PG8_STAGE(PG8_SA(0, 1), a2, v2[1]);
            PG8_WAIT_V(8); PG8_WAIT_L(0); PG8_BAR; PG8_MMA(0, 0, At, B0); PG8_MMA(0, 1, At, B1); PG8_BAR; PG8_SCHED;
            PG8_LDA(At, 1, 1); PG8_STAGE(PG8_SB(1, 0), b3, voffB); PG8_STAGE(PG8_SB(1, 1), b3 + hstep, voffB); PG8_STAGE(PG8_SA(1, 0), a3, v2[0]);
            PG8_WAIT_V(8); PG8_WAIT_L(0); PG8_BAR; PG8_MMA(1, 0, At, B0); PG8_MMA(1, 1, At, B1); PG8_BAR; PG8_SCHED;
        }
        if (wr == 0) PG8_BAR;
        E(acc, cur, wr, wc, fr, fq);
#if defined(PROBE_EPI2)
        if (Epi::PROBE2) E(acc, cur, wr, wc, fr, fq);
#endif
#if defined(PROBE_EPI3)
        if (Epi::PROBE2) {
#if PROBE_EPI3 == 2
            const int jb = 228 * 1048576 + (int)blockIdx.x * 131072 + (wr * 64 + fr) * 1024 + (wc * 32 + 8 * fq) * 2;
#define PEPI3_OFF(a, b, m) (((a) * 128 + (m) * 16) * 1024 + (b) * 256)
#else
            const int jb = 228 * 1048576 + ((int)(blockIdx.x * 8 + wid) * 16) * 1024 + (tid & 63) * 16;
#define PEPI3_OFF(a, b, m) ((((a) * 2 + (b)) * 4 + (m)) * 1024)
#endif
#pragma unroll
            for (int a = 0; a < 2; ++a)
#pragma unroll
                for (int b = 0; b < 2; ++b)
#pragma unroll
                    for (int m = 0; m < 4; ++m) { u32x4 x; x.x = cvt_pk_bf16(acc[a][b][m][0][0], acc[a][b][m][0][1]); x.y = cvt_pk_bf16(acc[a][b][m][0][2], acc[a][b][m][0][3]); x.z = cvt_pk_bf16(acc[a][b][m][1][0], acc[a][b][m][1][1]); x.w = cvt_pk_bf16(acc[a][b][m][1][2], acc[a][b][m][1][3]);
                        __builtin_amdgcn_raw_buffer_store_b128(x, E.wt.rs, jb, PEPI3_OFF(a, b, m), 0); }
        }
#endif
        if (!has_next) break;
#pragma unroll
        for (int a = 0; a < 2; ++a)
#pragma unroll
            for (int b = 0; b < 2; ++b)
#pragma unroll
                for (int m = 0; m < 4; ++m)
#pragma unroll
                    for (int n = 0; n < 2; ++n) acc[a][b][m][n] = (f32x4){z0, z0, z0, z0};
        cur = nxt; cA = nA; cB = nB; ++ui;
        if (GATHER) {
#pragma unroll
            for (int h = 0; h < 2; ++h)
#pragma unroll
                for (int i = 0; i < 2; ++i) voA[h][i] = voN[h][i];
        }
        if (wr == 1) PG8_BAR;
    }
    PG8_WAIT_V(0);
    PG8_BAR;
#undef PG8_VOA
#undef PG8_SA
#undef PG8_SB
#undef PG8_STAGE
#undef PG8_LDA
#undef PG8_LDB
#undef PG8_MMA
#undef PG8_WAIT_V
#undef PG8_WAIT_L
#undef PG8_BAR
#undef PG8_SCHED
}
struct DenseOrder {
    const char* A; const char* Bt; int K, nM, nN, nwg, G, c, pn0;
    __device__ __forceinline__ void init(const void* A_, const void* Bt_, int M, int N, int K_, int G_, int c_, int pn0_ = 0) { A = (const char*)A_; Bt = (const char*)Bt_; K = K_; nM = M / BM; nN = N / BM; nwg = nM * nN; G = G_; c = c_; pn0 = pn0_; }
    __device__ __forceinline__ bool next(int i, GUnit& u) const {
        const long L = (long)i * G + c; if (L >= nwg) return false;
        int wgid = (int)L; { const int q = nwg / 8, r = nwg % 8, xcd = wgid % 8, off = wgid / 8; wgid = (xcd < r ? xcd * (q + 1) : r * (q + 1) + (xcd - r) * q) + off; }
        const int nig = 8 * nN, gid = wgid / nig, fm = gid * 8, gsz = (nM - fm) < 8 ? (nM - fm) : 8;
        u.pm = fm + ((wgid % nig) % gsz); u.pn = pn0 + (wgid % nig) / gsz;
        u.A = A + (size_t)u.pm * BM * K * 2; u.B = Bt + (size_t)u.pn * BM * K * 2; u.e = 0; u.row0 = 0; u.nrows = BM; u.rtg = 0; return true;
    }
    __device__ __forceinline__ int arow(const GUnit&, int) const { return 0; }
    static constexpr int mode = 0;
    struct Early {};
    __device__ __forceinline__ void early_reset(Early&) const {}
    __device__ __forceinline__ void a_early(const GUnit&, Early&) const {}
    __device__ __forceinline__ void a_ready(const GUnit&, int, Early&) const {}
};

struct WtBuf { __amdgpu_buffer_rsrc_t rs; const unsigned char* base; };
__device__ __forceinline__ WtBuf wt_make(const unsigned char* base) { WtBuf w; w.rs = __builtin_amdgcn_make_buffer_rsrc((void*)base, 0, 0x7fffffff, 0x00020000); w.base = base; return w; }
__device__ __forceinline__ void wt_store16(const WtBuf& w, const void* p, u32x4 v) {
#if defined(WT_STORES) && WT_STORES
    __builtin_amdgcn_raw_buffer_store_b128(v, w.rs, (int)(unsigned)((const unsigned char*)p - w.base), 0, 16);
#else
    *(GAS u32x4*)p = v;
#endif
}
__device__ __forceinline__ void st8w(const WtBuf& w, bf16_t* p, f32x4 v0, f32x4 v1) {
    u32x4 x; x.x = cvt_pk_bf16(v0[0], v0[1]); x.y = cvt_pk_bf16(v0[2], v0[3]); x.z = cvt_pk_bf16(v1[0], v1[1]); x.w = cvt_pk_bf16(v1[2], v1[3]);
    wt_store16(w, p, x);
}
__device__ __forceinline__ u32x4 lane_tr(u32x4 x, int pa) {
    x.x = (unsigned)__builtin_amdgcn_ds_bpermute(pa, (int)x.x); x.y = (unsigned)__builtin_amdgcn_ds_bpermute(pa, (int)x.y); x.z = (unsigned)__builtin_amdgcn_ds_bpermute(pa, (int)x.z); x.w = (unsigned)__builtin_amdgcn_ds_bpermute(pa, (int)x.w); return x; }
__device__ __forceinline__ void st8p(const WtBuf& w, bf16_t* p, f32x4 v0, f32x4 v1, int pa) {
    u32x4 x; x.x = cvt_pk_bf16(v0[0], v0[1]); x.y = cvt_pk_bf16(v0[2], v0[3]); x.z = cvt_pk_bf16(v1[0], v1[1]); x.w = cvt_pk_bf16(v1[2], v1[3]);
#if defined(EPI_TR) && EPI_TR
    x = lane_tr(x, pa);
#endif
    wt_store16(w, p, x);
}
__device__ __forceinline__ void st8(bf16_t* p, f32x4 v0, f32x4 v1) {
    u32x4 w; w.x = cvt_pk_bf16(v0[0], v0[1]); w.y = cvt_pk_bf16(v0[2], v0[3]); w.z = cvt_pk_bf16(v1[0], v1[1]); w.w = cvt_pk_bf16(v1[2], v1[3]);
    *(GAS u32x4*)p = w;
}

struct EpiProj {
    static constexpr bool PROBE2 = true;
    static constexpr bool PERM = true;
    static constexpr bool PERM16 = false;
    bf16_t *QA, *KA, *VA, *QH, *IH, *OG; float* GH; const float* ct; const float* st; const float* lbp; int layer; WtBuf wt;
    __device__ __forceinline__ void operator()(const f32x4 (&acc)[2][2][4][2], const GUnit& u, int wr, int wc, int fr, int fq) const {
        const int kind = u.pn >> 1, sub = u.pn & 1;
        const int row0 = u.pm * BM + wr * 64 + fr;
#if defined(EPI_TR) && EPI_TR
        const int ln_ = fq * 16 + fr, frs = ln_ >> 2, fqs = ln_ & 3, pa = (16 * fqs + frs) << 2;
#else
        const int frs = fr, fqs = fq, pa = 0;
#endif
        const int rowS = u.pm * BM + wr * 64 + frs;
        if (kind <= 1) {
            bf16_t* dst = (kind == 0 ? QA : KA); const float sc = (kind == 0) ? QSCALE : 1.0f;
            const int head = 4 * sub + wc;
#if defined(EPI_HOIST) && (EPI_HOIST & 2)
            f32x4 o1[2][4][2], o2[2][4][2];
#pragma unroll
            for (int ai = 0; ai < 2; ++ai) {
                f32x4 cs[4][4];
#pragma unroll
                for (int m = 0; m < 4; ++m) { const size_t to = (size_t)(row0 + ai * HALF + m * 16) * 32 + 8 * fq;
                    cs[m][0] = *(const GAS f32x4*)(ct + to); cs[m][1] = *(const GAS f32x4*)(ct + to + 4); cs[m][2] = *(const GAS f32x4*)(st + to); cs[m][3] = *(const GAS f32x4*)(st + to + 4); }
#pragma unroll
                for (int m = 0; m < 4; ++m) {
                    const f32x4 a0 = acc[ai][0][m][0], a1 = acc[ai][0][m][1], b0 = acc[ai][1][m][0], b1 = acc[ai][1][m][1];
                    o1[ai][m][0] = (a0 * cs[m][0] - b0 * cs[m][2]) * sc; o1[ai][m][1] = (a1 * cs[m][1] - b1 * cs[m][3]) * sc;
                    o2[ai][m][0] = (a0 * cs[m][2] + b0 * cs[m][0]) * sc; o2[ai][m][1] = (a1 * cs[m][3] + b1 * cs[m][1]) * sc; }
                asm volatile("" ::: "memory"); __builtin_amdgcn_sched_barrier(0);
            }
#pragma unroll
            for (int ai = 0; ai < 2; ++ai)
#pragma unroll
                for (int m = 0; m < 4; ++m) { bf16_t* p = dst + (size_t)(rowS + ai * HALF + m * 16) * AW + head * HD + 8 * fqs;
                    st8p(wt, p, o1[ai][m][0], o1[ai][m][1], pa); st8p(wt, p + 32, o2[ai][m][0], o2[ai][m][1], pa); }
#else
            f32x4 cn0 = *(const GAS f32x4*)(ct + (size_t)row0 * 32 + 8 * fq), cn1 = *(const GAS f32x4*)(ct + (size_t)row0 * 32 + 8 * fq + 4);
            f32x4 sn0 = *(const GAS f32x4*)(st + (size_t)row0 * 32 + 8 * fq), sn1 = *(const GAS f32x4*)(st + (size_t)row0 * 32 + 8 * fq + 4);
#pragma unroll
            for (int g = 0; g < 8; ++g) { const int ai = g >> 2, m = g & 3, r = row0 + ai * HALF + m * 16;
                const f32x4 c0 = cn0, c1 = cn1, s0 = sn0, s1 = sn1;
                if (g < 7) { const int r2 = row0 + ((g + 1) >> 2) * HALF + ((g + 1) & 3) * 16;
                    cn0 = *(const GAS f32x4*)(ct + (size_t)r2 * 32 + 8 * fq); cn1 = *(const GAS f32x4*)(ct + (size_t)r2 * 32 + 8 * fq + 4);
                    sn0 = *(const GAS f32x4*)(st + (size_t)r2 * 32 + 8 * fq); sn1 = *(const GAS f32x4*)(st + (size_t)r2 * 32 + 8 * fq + 4); }
                const f32x4 a0 = acc[ai][0][m][0], a1 = acc[ai][0][m][1], b0 = acc[ai][1][m][0], b1 = acc[ai][1][m][1];
                const f32x4 o10 = (a0 * c0 - b0 * s0) * sc, o11 = (a1 * c1 - b1 * s1) * sc, o20 = (a0 * s0 + b0 * c0) * sc, o21 = (a1 * s1 + b1 * c1) * sc;
                bf16_t* p = dst + (size_t)(r - row0 + rowS) * AW + head * HD + 8 * fqs;
                st8p(wt, p, o10, o11, pa); st8p(wt, p + 32, o20, o21, pa); }
#endif
        } else if (kind == 4) {
#pragma unroll
            for (int bj = 0; bj < 2; ++bj) { const int col = sub * 256 + bj * HALF + wc * 32 + 8 * fq;
                f32x4 lb0 = (f32x4){0.f, 0.f, 0.f, 0.f}, lb1 = lb0;
                if (layer == 1) { const f32x4 p0 = *(const GAS f32x4*)(lbp + col), p1 = *(const GAS f32x4*)(lbp + col + 4), q0 = *(const GAS f32x4*)(lbp + HW + col), q1 = *(const GAS f32x4*)(lbp + HW + col + 4);
#pragma unroll
                    for (int k = 0; k < 4; ++k) { lb0[k] = __builtin_amdgcn_rcpf(1.f + __expf(p0[k] - q0[k])); lb1[k] = __builtin_amdgcn_rcpf(1.f + __expf(p1[k] - q1[k])); } }
#pragma unroll
                for (int ai = 0; ai < 2; ++ai)
#pragma unroll
                    for (int m = 0; m < 4; ++m) { const int r = row0 + ai * HALF + m * 16; f32x4 g0, g1;
#pragma unroll
                        for (int k = 0; k < 4; ++k) {
#if defined(F0_FAST) && F0_FAST
                            if (layer == 0) { g0[k] = -__logf(1.f + __expf(-acc[ai][bj][m][0][k])); g1[k] = -__logf(1.f + __expf(-acc[ai][bj][m][1][k])); }
                            else
#endif
                            { g0[k] = __logf(lb0[k] + (1.f - lb0[k]) * sigm_f(acc[ai][bj][m][0][k])); g1[k] = __logf(lb1[k] + (1.f - lb1[k]) * sigm_f(acc[ai][bj][m][1][k])); } }
                        st8p(wt, (bf16_t*)GH + (size_t)(r - row0 + rowS) * HW + col - 8 * fq + 8 * fqs, g0, g1, pa); asm volatile("" ::: "memory"); } }
        } else {
            bf16_t* dst = (kind == 2) ? VA : (kind == 3) ? QH : (kind == 5) ? IH : OG;
            #if defined(SIG_IN_MN) && SIG_IN_MN
            const int act = (kind == 3) ? 1 : 0;
#else
            const int act = (kind == 3) ? 1 : (kind == 6) ? 2 : 0;
#endif
#pragma unroll
            for (int ai = 0; ai < 2; ++ai)
#pragma unroll
                for (int m = 0; m < 4; ++m) { const int r = row0 + ai * HALF + m * 16;
#pragma unroll
                    for (int bj = 0; bj < 2; ++bj) { f32x4 v0 = acc[ai][bj][m][0], v1 = acc[ai][bj][m][1];
                        if (act) {
#pragma unroll
                            for (int k = 0; k < 4; ++k) { const float s0 = sigm_f(v0[k]), s1 = sigm_f(v1[k]); v0[k] = (act == 1) ? v0[k] * s0 : s0; v1[k] = (act == 1) ? v1[k] * s1 : s1; } }
                        st8p(wt, dst + (size_t)(r - row0 + rowS) * 512 + sub * 256 + bj * HALF + wc * 32 + 8 * fqs, v0, v1, pa); } }
        }
    }
};

#if defined(OG_U8) && OG_U8
struct EpiGateH {
    static constexpr bool PROBE2 = false;
    static constexpr bool PERM = true;
    static constexpr bool PERM16 = true;
    unsigned char* OG8; WtBuf wt;
    __device__ __forceinline__ void operator()(const f32x4 (&acc)[2][2][4][2], const GUnit& u, int wr, int wc, int fr, int fq) const {
        const int row0 = u.pm * BM + wr * 64 + fr, col0 = (u.pn - 12) * BM + wc * 64 + 16 * fq;
#pragma unroll
        for (int ai = 0; ai < 2; ++ai)
#pragma unroll
            for (int m = 0; m < 4; ++m) { u32x4 o;
#pragma unroll
                for (int q = 0; q < 4; ++q) { const f32x4 v = acc[ai][q >> 1][m][q & 1]; unsigned d_ = 0u;
                    d_ = __builtin_amdgcn_cvt_pk_u8_f32(sigm_f(v[0]) * 255.0f, 0, d_); d_ = __builtin_amdgcn_cvt_pk_u8_f32(sigm_f(v[1]) * 255.0f, 1, d_);
                    d_ = __builtin_amdgcn_cvt_pk_u8_f32(sigm_f(v[2]) * 255.0f, 2, d_); d_ = __builtin_amdgcn_cvt_pk_u8_f32(sigm_f(v[3]) * 255.0f, 3, d_); o[q] = d_; }
                wt_store16(wt, OG8 + (size_t)(row0 + ai * HALF + m * 16) * HW + col0, o); }
    }
};
#endif
constexpr int RING_OFF = 0, RING_BYTES = 131072;
constexpr int MISC_OFF = RING_BYTES + 320;
constexpr int LDS_BYTES = 147456;

struct Args {
    const float *x, *c; const int* positions; const float *w_in, *w_out, *attn_norm, *hgrn_norm, *lb_params, *ada_w, *ada_b, *w_router, *b_router, *w_gate, *w_up, *w_down, *final_norm;
    float* out; unsigned char* ws; int ph_lo, ph_hi, hybrid, pad;
};
struct Frame {
    LAS unsigned char* lds; volatile LAS unsigned* MISC; gu32* ctl; int tid, lane, wave, G, vcu; unsigned char* ws;
};

__device__ __forceinline__ void transpose_item(const float* W, int ldn, int k0, int col0, bf16_t* WT, int Kd, int drow0, LAS float* scr, int lane) {
    float tv[32];
#pragma unroll
    for (int i = 0; i < 32; ++i) tv[i] = NT_LOAD(((const GAS float*)W) + (size_t)(k0 + 2 * i + (lane >> 5)) * ldn + col0 + (lane & 31));
#pragma unroll
    for (int i = 0; i < 32; ++i) scr[(2 * i + (lane >> 5)) * 33 + (lane & 31)] = tv[i];
    LDS_WAIT(); asm volatile("" ::: "memory");
    const int c = lane & 7;
#pragma unroll
    for (int j = 0; j < 4; ++j) { const int n = (lane >> 3) + 8 * j; const LAS float* s = scr + (8 * c) * 33 + n;
        u32x4 o; o.x = pk2(s[0 * 33], s[1 * 33]); o.y = pk2(s[2 * 33], s[3 * 33]); o.z = pk2(s[4 * 33], s[5 * 33]); o.w = pk2(s[6 * 33], s[7 * 33]);
        *(GAS u32x4*)(WT + (size_t)(drow0 + n) * Kd + k0 + 8 * c) = o; }
    LDS_WAIT(); asm volatile("" ::: "memory");
}
__device__ __forceinline__ int win_src_col(int n0) {
    const int tile = n0 >> 8, rho = n0 & 255;
    if (tile < 4) { const int base = (tile >> 1) * 512, hh = (rho & 127) >> 5, half = rho >> 7; return base + (4 * (tile & 1) + hh) * 64 + 32 * half; }
    return n0;
}
__device__ __forceinline__ void convert_weights(const Frame& F, const Args& a, int l, int part) {
    LAS float* scr = (LAS float*)(F.lds + RING_OFF + F.wave * 16384);
    const int gw = F.vcu * NWAVES + F.wave, NGW = F.G * NWAVES;
    constexpr int I_IN = 16 * 112, I_OUT = 16 * 32, I_GU = 16 * 32 * NE, I_DN = 8 * 32 * NE;
    bf16_t* Win = (bf16_t*)(F.ws + WS_WIN); bf16_t* Wout = (bf16_t*)(F.ws + WS_WOUT); bf16_t* Wgu = (bf16_t*)(F.ws + WS_WGU); bf16_t* Wd = (bf16_t*)(F.ws + WS_WD);
    const int lo = (part & 1) ? 0 : I_IN + I_OUT, hi = (part & 2) ? I_IN + I_OUT + I_GU + I_DN : I_IN + I_OUT;
    for (int it = lo + gw; it < hi; it += NGW) {
        int r = it;
        if (r < I_IN) { const int kb = r / 112, grp = r % 112; transpose_item(a.w_in + (size_t)l * D * INC, INC, kb * 64, win_src_col(grp * 32), Win, D, grp * 32, scr, F.lane); continue; } r -= I_IN;
        if (r < I_OUT) { const int kb = r / 32, grp = r % 32; transpose_item(a.w_out + (size_t)l * D * D, D, kb * 64, grp * 32, Wout, D, grp * 32, scr, F.lane); continue; } r -= I_OUT;
        if (r < I_GU) { const int e = r / 512, q = r % 512, kb = q / 32, grp = q % 32, drow0 = grp * 32, tile = drow0 >> 8, rho = drow0 & 255;
            const float* src = (rho < 128 ? a.w_gate : a.w_up) + ((size_t)l * NE + e) * D * FF;
            transpose_item(src, FF, kb * 64, 128 * tile + (rho & 127), Wgu + (size_t)e * 1024 * D, D, drow0, scr, F.lane); continue; } r -= I_GU;
        { const int e = r / 256, q = r % 256, kb = q / 32, grp = q % 32;
            transpose_item(a.w_down + ((size_t)l * NE + e) * FF * D, D, kb * 64, grp * 32, Wd + (size_t)e * D * FF, FF, grp * 32, scr, F.lane); }
    }
}
__device__ __forceinline__ void p0_prologue(const Frame& F, const Args& a) {
    const int gw = F.vcu * NWAVES + F.wave, NGW = F.G * NWAVES;
    float* adap = (float*)(F.ws + WS_ADAP);
#if defined(PRO_POLISH) && PRO_POLISH
    if (NGW >= DEPTH * 24 * 32) {
        const int it = gw; const bool has = it < DEPTH * 24 * 32;
        const int l = it / (24 * 32), q = it % (24 * 32), cb = q / 32, kc = q % 32, col = cb * 256 + lane_id_asm() * 4;
        f32x4 w[32];
        if (has) { const float* W = a.ada_w + ((size_t)l * D + kc * 32) * 6 * D + col;
#pragma unroll
            for (int k = 0; k < 32; ++k) w[k] = NT_LOAD((const GAS f32x4*)(W + (size_t)k * 6 * D)); }
        { float* ct = (float*)(F.ws + WS_ROPE_C); float* st = (float*)(F.ws + WS_ROPE_S);
          for (int i = F.vcu * NTHR + F.wave * 64 + lane_id_asm(); i < T * 32; i += F.G * NTHR) {
              const int t = i >> 5, j = i & 31;
              const float inv = exp2f(-(float)j * (13.287712379549449f / 32.0f));
              const float ang = (float)a.positions[t] * inv; float sn, cs; sincosf(ang, &sn, &cs);
              ct[i] = cs; st[i] = sn; } }
        if (has) {
            f32x4 a0 = (f32x4){0.f, 0.f, 0.f, 0.f}, a1 = a0;
#pragma unroll
            for (int k = 0; k < 32; ++k) { const float c0 = silu_f(a.c[kc * 32 + k]), c1 = silu_f(a.c[D + kc * 32 + k]); a0 += w[k] * c0; a1 += w[k] * c1; }
            *(GAS f32x4*)(adap + (((size_t)l * 32 + kc) * 2 + 0) * 6 * D + col) = a0;
            *(GAS f32x4*)(adap + (((size_t)l * 32 + kc) * 2 + 1) * 6 * D + col) = a1; }
        return;
    }
#endif
    for (int it = gw; it < DEPTH * 24 * 32; it += NGW) {
        const int l = it / (24 * 32), q = it % (24 * 32), cb = q / 32, kc = q % 32, col = cb * 256 + lane_id_asm() * 4;
        const float* W = a.ada_w + ((size_t)l * D + kc * 32) * 6 * D + col;
        f32x4 w[32];
#pragma unroll
        for (int k = 0; k < 32; ++k) w[k] = NT_LOAD((const GAS f32x4*)(W + (size_t)k * 6 * D));
        f32x4 a0 = (f32x4){0.f, 0.f, 0.f, 0.f}, a1 = a0;
#pragma unroll
        for (int k = 0; k < 32; ++k) { const float c0 = silu_f(a.c[kc * 32 + k]), c1 = silu_f(a.c[D + kc * 32 + k]); a0 += w[k] * c0; a1 += w[k] * c1; }
        *(GAS f32x4*)(adap + (((size_t)l * 32 + kc) * 2 + 0) * 6 * D + col) = a0;
        *(GAS f32x4*)(adap + (((size_t)l * 32 + kc) * 2 + 1) * 6 * D + col) = a1;
    }
    float* ct = (float*)(F.ws + WS_ROPE_C); float* st = (float*)(F.ws + WS_ROPE_S);
    for (int i = F.vcu * NTHR + F.wave * 64 + lane_id_asm(); i < T * 32; i += F.G * NTHR) {
        const int t = i >> 5, j = i & 31;
        const float inv = exp2f(-(float)j * (13.287712379549449f / 32.0f));
        const float ang = (float)a.positions[t] * inv; float sn, cs; sincosf(ang, &sn, &cs);
        ct[i] = cs; st[i] = sn;
    }
}
__device__ __forceinline__ void p1_prologue(const Frame& F, const Args& a) {
    const float* adap = (const float*)(F.ws + WS_ADAP); float* mod = (float*)(F.ctl + CW_MOD);
#if defined(PRO_POLISH) && PRO_POLISH
    const int per_ = (DEPTH * NB * 6 * D + F.G - 1) / F.G;
    for (int i = F.vcu * per_ + F.tid; i < DEPTH * NB * 6 * D && F.tid < per_; i += F.G * per_) {
#else
    for (int i = F.vcu * NTHR + F.tid; i < DEPTH * NB * 6 * D; i += F.G * NTHR) {
#endif
        const int n = i % (6 * D), b = (i / (6 * D)) % NB, l = i / (NB * 6 * D);
        float p[32];
#pragma unroll
        for (int kc = 0; kc < 32; ++kc) p[kc] = adap[(((size_t)l * 32 + kc) * 2 + b) * 6 * D + n];
        float s = a.ada_b[(size_t)l * 6 * D + n];
#pragma unroll
        for (int kc = 0; kc < 32; ++kc) s += p[kc];
        mod[i] = s;
    }
    convert_weights(F, a, 0, 3);
}
__device__ __forceinline__ void norm_rows(const Frame& F, const float* x, const float* mod_l  , int part  , bf16_t* out) {
    const int gw = F.vcu * NWAVES + F.wave, NGW = F.G * NWAVES;
    if (gw >= T) return;
    f32x4 vn[4];
    { const GAS f32x4* xr = (const GAS f32x4*)(x + (size_t)gw * D) + F.lane;
#pragma unroll
      for (int j = 0; j < 4; ++j) vn[j] = xr[64 * j]; }
#pragma unroll 1
    for (int row = gw; row < T; row += NGW) {
        f32x4 v[4];
#pragma unroll
        for (int j = 0; j < 4; ++j) v[j] = vn[j];
        { const int nrow = (row + NGW < T) ? row + NGW : row; const GAS f32x4* xr = (const GAS f32x4*)(x + (size_t)nrow * D) + F.lane;
#pragma unroll
          for (int j = 0; j < 4; ++j) vn[j] = xr[64 * j]; }
        const float* m = mod_l + (size_t)(row / S) * 6 * D + part * D;
        float ss = 0.f;
#pragma unroll
        for (int j = 0; j < 4; ++j) ss += (v[j].x * v[j].x + v[j].y * v[j].y) + (v[j].z * v[j].z + v[j].w * v[j].w);
        const float r = 1.0f / sqrtf(wave_sum(ss) * (1.f / D) + EPS);
        GAS unsigned long long* o8 = (GAS unsigned long long*)(out + (size_t)row * D) + F.lane;
#pragma unroll
        for (int j = 0; j < 4; ++j) { const f32x4 sh = *((const GAS f32x4*)m + F.lane + 64 * j), sc = *((const GAS f32x4*)(m + D) + F.lane + 64 * j);
            const f32x4 h = v[j] * r * (sc + 1.0f) + sh;
            o8[64 * j] = (unsigned long long)pk2(h.x, h.y) | ((unsigned long long)pk2(h.z, h.w) << 32); }
    }
}
typedef short v4i16_t __attribute__((ext_vector_type(4)));
__device__ __forceinline__ s16x4 vtr(const LAS unsigned char* p) { return __builtin_bit_cast(s16x4, __builtin_amdgcn_ds_read_tr16_b64_v4i16((LAS v4i16_t*)p)); }
__device__ __forceinline__ bf16x8 cat4(s16x4 a, s16x4 b) { return (bf16x8){a[0], a[1], a[2], a[3], b[0], b[1], b[2], b[3]}; }
constexpr int ATT_UNITS = NB * NH * 3 * 32;
struct AttnUnit { int b, h, p, d, r, ub; };
__device__ __forceinline__ void attn_decode(int it, AttnUnit& a) {
    const int g = it & 31, p = (it >> 5) % 3, bh = (it >> 5) / 3;
    a.b = bh >> 3; a.h = bh & 7; a.p = p; a.d = (p == 0) ? 1 : (p == 1) ? 4 : 16;
    const int per = 32 / a.d;
    a.r = g / per; a.ub = g % per;
}
__device__ __forceinline__ void attn_phase(const Frame& F) {
    const GAS bf16_t* QA = (const GAS bf16_t*)(F.ws + WS_QA); const GAS bf16_t* KA = (const GAS bf16_t*)(F.ws + WS_KA); const GAS bf16_t* VA = (const GAS bf16_t*)(F.ws + WS_VA);
    GAS bf16_t* PART = (GAS bf16_t*)(F.ws + WS_PART); GAS float* LSE = (GAS float*)(F.ws + WS_LSE);
    LAS unsigned char* img = F.lds + RING_OFF;
    const int lane = F.lane, w = F.wave, tid = F.tid;
    const int qi = lane & 31, hf = lane >> 5;
    const int kroff = qi * 128, kswz = (qi & 2) << 1;
    const int tq = (lane & 15) >> 2, tp = lane & 3, tg = (lane >> 4) & 1, tsw = (tq & 2) << 1;
    const int trb0 = (4 * hf + tq) * 128 + (((2 * tg + (tp >> 1)) ^ tsw) * 16) + 8 * (tp & 1);
    const int trb1 = (4 * hf + tq) * 128 + (((4 + 2 * tg + (tp >> 1)) ^ tsw) * 16) + 8 * (tp & 1);
    int it = F.vcu;
    if (it >= ATT_UNITS) return;
    AttnUnit cur; attn_decode(it, cur);
    bf16x8 kr[6], vr[6];
#define ATT_FETCH(U) do { _Pragma("unroll") for (int i_ = 0; i_ < 6; ++i_) { const int q_ = tid + NTHR * i_, key_ = q_ >> 3, ch_ = q_ & 7; int pos_ = 256 * (U).ub - 128 + key_; pos_ = pos_ < 0 ? 0 : pos_; \
        const size_t row_ = (size_t)(U).b * S + (size_t)pos_ * (U).d + (U).r; kr[i_] = *(const GAS bf16x8*)(KA + row_ * AW + (U).h * HD + ch_ * 8); vr[i_] = *(const GAS bf16x8*)(VA + row_ * AW + (U).h * HD + ch_ * 8); } } while (0)
#define ATT_PUT() do { _Pragma("unroll") for (int i_ = 0; i_ < 6; ++i_) { const int q_ = tid + NTHR * i_, key_ = q_ >> 3, ch_ = q_ & 7, row_ = key_ & 31; \
        LAS unsigned char* d_ = img + (key_ >> 5) * 8192 + row_ * 128 + ((ch_ ^ ((row_ & 2) << 1)) * 16); *(LAS bf16x8*)d_ = kr[i_]; *(LAS bf16x8*)(d_ + 4096) = vr[i_]; } } while (0)
    ATT_FETCH(cur);
    bf16x8 qf[4];
    { const GAS bf16x8* qp = (const GAS bf16x8*)(QA + ((size_t)cur.b * S + (size_t)(256 * cur.ub + 32 * w + qi) * cur.d + cur.r) * AW + cur.h * HD + 32 * hf);
#pragma unroll
      for (int ks = 0; ks < 4; ++ks) qf[ks] = qp[ks]; }
    ATT_PUT();
    __syncthreads();
    for (;;) {
        const int nit = it + F.G; const bool more = nit < ATT_UNITS;
        AttnUnit nx = cur; if (more) attn_decode(nit, nx);
        ATT_FETCH(nx);
        bf16x8 nq[4];
        { const GAS bf16x8* qp = (const GAS bf16x8*)(QA + ((size_t)nx.b * S + (size_t)(256 * nx.ub + 32 * w + qi) * nx.d + nx.r) * AW + nx.h * HD + 32 * hf);
#pragma unroll
          for (int ks = 0; ks < 4; ++ks) nq[ks] = qp[ks]; }
        const int U0 = 256 * cur.ub + 32 * w;
        const size_t rowq = (size_t)cur.b * S + (size_t)(U0 + qi) * cur.d + cur.r;
        const int kb0 = (U0 >= 128) ? 0 : ((128 - U0) >> 5);
        float zz = 0.f; asm volatile("" : "+v"(zz));
        f32x16 o0, o1;
#pragma unroll
        for (int i = 0; i < 16; ++i) { o0[i] = zz; o1[i] = zz; }
        float m = -INFINITY, l = 0.f;
#pragma unroll
        for (int kb = 0; kb < 5; ++kb) {
            if (kb >= kb0) {
            const LAS unsigned char* kimg = img + (w + kb) * 8192; const LAS unsigned char* vimg = kimg + 4096;
            f32x16 s;
#pragma unroll
            for (int i = 0; i < 16; ++i) s[i] = 0.f;
#pragma unroll
            for (int ks = 0; ks < 4; ++ks) { const bf16x8 kf = *(const LAS bf16x8*)(kimg + kroff + (((4 * hf + ks) ^ kswz) * 16)); s = __builtin_amdgcn_mfma_f32_32x32x16_bf16(kf, qf[ks], s, 0, 0, 0); }
            if (kb == 0) {
#pragma unroll
                for (int i = 0; i < 16; ++i) { const int kk = (i & 3) + 8 * (i >> 2) + 4 * hf; if (kk < qi) s[i] = -INFINITY; }
            }
            if (kb == 4) {
#pragma unroll
                for (int i = 0; i < 16; ++i) { const int kk = (i & 3) + 8 * (i >> 2) + 4 * hf; if (kk > qi) s[i] = -INFINITY; }
            }
            float mx = s[0];
#pragma unroll
            for (int i = 1; i < 16; ++i) mx = fmaxf(mx, s[i]);
            mx = fmaxf(mx, __builtin_bit_cast(float, __builtin_amdgcn_ds_bpermute((lane ^ 32) << 2, __builtin_bit_cast(int, mx))));
            const float mn = fmaxf(m, mx), alpha = __builtin_amdgcn_exp2f(m - mn);
            m = mn;
            float rs = 0.f;
#pragma unroll
            for (int i = 0; i < 16; ++i) { s[i] = __builtin_amdgcn_exp2f(s[i] - mn); rs += s[i]; }
            l = l * alpha + rs;
            if (__builtin_amdgcn_ballot_w64(alpha != 1.0f) != 0) {
#pragma unroll
                for (int i = 0; i < 16; ++i) { o0[i] *= alpha; o1[i] *= alpha; }
            }
            bf16x8 pf[2];
#pragma unroll
            for (int s2 = 0; s2 < 2; ++s2) {
                u32x4 wv; wv.x = cvt_pk_bf16(s[8 * s2 + 0], s[8 * s2 + 1]); wv.y = cvt_pk_bf16(s[8 * s2 + 2], s[8 * s2 + 3]); wv.z = cvt_pk_bf16(s[8 * s2 + 4], s[8 * s2 + 5]); wv.w = cvt_pk_bf16(s[8 * s2 + 6], s[8 * s2 + 7]);
                pf[s2] = __builtin_bit_cast(bf16x8, wv);
            }
#pragma unroll
            for (int s2 = 0; s2 < 2; ++s2) {
                const bf16x8 v0 = cat4(vtr(vimg + trb0 + (16 * s2) * 128), vtr(vimg + trb0 + (16 * s2 + 8) * 128));
                const bf16x8 v1 = cat4(vtr(vimg + trb1 + (16 * s2) * 128), vtr(vimg + trb1 + (16 * s2 + 8) * 128));
                o0 = __builtin_amdgcn_mfma_f32_32x32x16_bf16(v0, pf[s2], o0, 0, 0, 0);
                o1 = __builtin_amdgcn_mfma_f32_32x32x16_bf16(v1, pf[s2], o1, 0, 0, 0);
            }
            }
        }
        l += __builtin_bit_cast(float, __builtin_amdgcn_ds_bpermute((lane ^ 32) << 2, __builtin_bit_cast(int, l)));
        const float inv = 1.0f / l;
#if defined(BR_FP8) && (BR_FP8 & 1)
        GAS unsigned char* op = (GAS unsigned char*)PART + (size_t)cur.p * T * AW + rowq * AW + cur.h * HD + 4 * hf;
#pragma unroll
        for (int c = 0; c < 4; ++c) {
            int w0 = __builtin_amdgcn_cvt_pk_fp8_f32(F8SAT(o0[4 * c] * inv), F8SAT(o0[4 * c + 1] * inv), 0, false); w0 = __builtin_amdgcn_cvt_pk_fp8_f32(F8SAT(o0[4 * c + 2] * inv), F8SAT(o0[4 * c + 3] * inv), w0, true);
            int w1 = __builtin_amdgcn_cvt_pk_fp8_f32(F8SAT(o1[4 * c] * inv), F8SAT(o1[4 * c + 1] * inv), 0, false); w1 = __builtin_amdgcn_cvt_pk_fp8_f32(F8SAT(o1[4 * c + 2] * inv), F8SAT(o1[4 * c + 3] * inv), w1, true);
            *(GAS int*)(op + 8 * c) = w0; *(GAS int*)(op + 32 + 8 * c) = w1;
        }
#else
        GAS bf16_t* op = PART + (size_t)cur.p * T * AW + rowq * AW + cur.h * HD + 4 * hf;
#pragma unroll
        for (int c = 0; c < 4; ++c) {
            u32x2 w0, w1;
            w0.x = cvt_pk_bf16(o0[4 * c] * inv, o0[4 * c + 1] * inv); w0.y = cvt_pk_bf16(o0[4 * c + 2] * inv, o0[4 * c + 3] * inv);
            w1.x = cvt_pk_bf16(o1[4 * c] * inv, o1[4 * c + 1] * inv); w1.y = cvt_pk_bf16(o1[4 * c + 2] * inv, o1[4 * c + 3] * inv);
            *(GAS u32x2*)(op + 8 * c) = w0; *(GAS u32x2*)(op + 32 + 8 * c) = w1;
        }
#endif
        if (hf == 0) LSE[(size_t)cur.p * T * NH + rowq * NH + cur.h] = m + __builtin_amdgcn_logf(l);
        if (!more) break;
        __syncthreads();
        ATT_PUT();
#pragma unroll
        for (int ks = 0; ks < 4; ++ks) qf[ks] = nq[ks];
        __syncthreads();
        cur = nx; it = nit;
    }
#undef ATT_FETCH
#undef ATT_PUT
    __syncthreads();
}
constexpr size_t WS_EREF = WS_DEC + 512 * 1024;
#if defined(HG_WIDE) && HG_WIDE
__device__ __forceinline__ void hgrn_tile_to_lds(const bf16_t* __restrict__ P, size_t row0, int h, int lane, LAS unsigned char* scr) {
    const GAS bf16x8* gp = (const GAS bf16x8*)((const GAS bf16_t*)P + (row0 + (lane >> 3)) * HW + h * 64) + (lane & 7);
    bf16x8 t[8];
#pragma unroll
    for (int j = 0; j < 8; ++j) t[j] = gp[(size_t)j * (8 * HW / 8)];
#pragma unroll
    for (int j = 0; j < 8; ++j) *(LAS bf16x8*)(scr + ((lane >> 3) + 8 * j) * 128 + (lane & 7) * 16) = t[j];
    LDS_WAIT(); asm volatile("" ::: "memory");
}
#endif
__device__ __forceinline__ void hgrn_load_gates(const float* __restrict__ GH, size_t row0, int h, int lane, float (&bc)[64], float (&kf)[64], LAS unsigned char* scr) {
#if defined(HG_WIDE) && HG_WIDE
    hgrn_tile_to_lds((const bf16_t*)GH, row0, h, lane, scr);
#pragma unroll
    for (int s = 0; s < 64; ++s) bc[s] = bf2f(*(const LAS unsigned short*)(scr + s * 128 + lane * 2));
    LDS_WAIT(); asm volatile("" ::: "memory");
#else
    const GAS bf16_t* gp = (const GAS bf16_t*)GH + row0 * HW + h * 64 + lane;
#pragma unroll
    for (int s = 0; s < 64; ++s) bc[s] = bf2f(gp[(size_t)s * HW]);
#endif
#pragma unroll
    for (int s = 0; s < 64; ++s) kf[s] = 1.0f - __expf(bc[s]);
#pragma unroll
    for (int s = 1; s < 64; ++s) bc[s] += bc[s - 1];
}
__device__ __forceinline__ void hgrn_v_image(const bf16_t* __restrict__ IH, size_t row0, int h, int lane, LAS unsigned char* img) {
    const GAS bf16x8* vp = (const GAS bf16x8*)(IH + (row0 + lane) * HW + h * 64);
    bf16x8 v[8];
#pragma unroll
    for (int c = 0; c < 8; ++c) v[c] = vp[c];
#pragma unroll
    for (int c = 0; c < 8; ++c) *(LAS bf16x8*)(img + (c >> 2) * 4096 + lane * 64 + (c & 3) * 16) = v[c];
}
__device__ __forceinline__ void hgrn_local(const Frame& F, int u) {
    const int lane = opqv(F.lane), h = u & 7, bn = u >> 3; const size_t row0 = (size_t)bn * 64;
    LAS unsigned char* kimg = F.lds + RING_OFF + F.wave * 16384; LAS unsigned char* vimg = kimg + 8192;
    float bc[64], kf[64];
    hgrn_load_gates((const float*)(F.ws + WS_GH), row0, h, lane, bc, kf, kimg);
    const float b63 = bc[63];
    ((GAS float*)(F.ws + WS_DEC))[(size_t)u * 64 + lane] = __expf(b63);
    ((GAS float*)(F.ws + WS_EREF))[(size_t)u * 64 + lane] = __expf(bc[31]);
#pragma unroll
    for (int s = 0; s < 64; ++s) *(LAS unsigned short*)(kimg + (lane >> 5) * 4096 + s * 64 + (lane & 31) * 2) = (unsigned short)cvt1_bf16(kf[s] * __expf(b63 - bc[s]));
    hgrn_v_image((const bf16_t*)(F.ws + WS_IH), row0, h, lane, vimg);
    const int hf = lane >> 5;
    const int trb = (8 * hf + ((lane & 15) >> 2)) * 64 + (((lane >> 4) & 1) * 16 + (lane & 3) * 4) * 2;
    float zz = 0.f; asm volatile("" : "+v"(zz));
    f32x16 acc[2][2];
#pragma unroll
    for (int a = 0; a < 2; ++a)
#pragma unroll
        for (int c = 0; c < 2; ++c)
#pragma unroll
            for (int i = 0; i < 16; ++i) acc[a][c][i] = zz;
#pragma unroll
    for (int st = 0; st < 4; ++st) {
        bf16x8 av[2], bk[2];
#pragma unroll
        for (int x = 0; x < 2; ++x) { av[x] = cat4(vtr(vimg + x * 4096 + trb + st * 1024), vtr(vimg + x * 4096 + trb + st * 1024 + 256));
                                      bk[x] = cat4(vtr(kimg + x * 4096 + trb + st * 1024), vtr(kimg + x * 4096 + trb + st * 1024 + 256)); }
#pragma unroll
        for (int db = 0; db < 2; ++db)
#pragma unroll
            for (int cb = 0; cb < 2; ++cb) acc[db][cb] = __builtin_amdgcn_mfma_f32_32x32x16_bf16(av[db], bk[cb], acc[db][cb], 0, 0, 0);
    }
    GAS bf16_t* sl = (GAS bf16_t*)(F.ws + WS_SLOC) + (size_t)u * 4096;
#pragma unroll
    for (int db = 0; db < 2; ++db)
#pragma unroll
        for (int cb = 0; cb < 2; ++cb)
#pragma unroll
            for (int i = 0; i < 16; ++i) sl[((i & 3) + 8 * (i >> 2) + 4 * hf + 32 * db) * 64 + (lane & 31) + 32 * cb] = (bf16_t)cvt1_bf16(acc[db][cb][i]);
}
__device__ __forceinline__ void hgrn_local_phase(const Frame& F) {
    const int gw = F.vcu * NWAVES + F.wave, NGW = F.G * NWAVES;
    for (int u = gw; u < NB * 128 * NH; u += NGW) hgrn_local(F, u);
}
__device__ __forceinline__ void hgrn_scan_phase(const Frame& F) {
    GAS unsigned* SL = (GAS unsigned*)(F.ws + WS_SLOC); const GAS float* DEC = (const GAS float*)(F.ws + WS_DEC); const GAS float* ER = (const GAS float*)(F.ws + WS_EREF);
    if ((int)blockIdx.x >= (int)gridDim.x / 2)
    for (int id = ((int)blockIdx.x - (int)gridDim.x / 2) * NTHR + F.tid; id < NB * NH * 2048; id += ((int)gridDim.x - (int)gridDim.x / 2) * NTHR) {
        const int bh = id >> 11, vk2 = id & 2047, b = bh >> 3, h = bh & 7, k = (2 * vk2) & 63;
        float st0 = 0.f, st1 = 0.f;
        for (int n0 = 0; n0 < 128; n0 += 16) {
            unsigned cur[16]; f32x2 dd[16], er[16];
#pragma unroll
            for (int j = 0; j < 16; ++j) { const size_t u = (size_t)(b * 128 + n0 + j) * 8 + h; cur[j] = SL[u * 2048 + vk2]; dd[j] = *(const GAS f32x2*)(DEC + u * 64 + k); er[j] = *(const GAS f32x2*)(ER + u * 64 + k); }
#pragma unroll
            for (int j = 0; j < 16; ++j) { const size_t u = (size_t)(b * 128 + n0 + j) * 8 + h;
                SL[u * 2048 + vk2] = cvt_pk_bf16(st0 * er[j].x, st1 * er[j].y);
                st0 = dd[j].x * st0 + bflo(cur[j]); st1 = dd[j].y * st1 + bfhi(cur[j]); }
        }
    }
}
__device__ __forceinline__ void hgrn_out(const Frame& F, int u) {
    const int lane = opqv(F.lane), h = u & 7, bn = u >> 3; const size_t row0 = (size_t)bn * 64;
    LAS unsigned char* qimg = F.lds + RING_OFF + F.wave * 16384; LAS unsigned char* kimg = qimg + 8192;
    {
        float bc[64], kf[64];
        hgrn_load_gates((const float*)(F.ws + WS_GH), row0, h, lane, bc, kf, kimg);
        const float bref = bc[31];
#if defined(HG_WIDE) && HG_WIDE
        hgrn_tile_to_lds((const bf16_t*)(F.ws + WS_QH), row0, h, lane, qimg);
#else
        const GAS bf16_t* qp = (const GAS bf16_t*)(F.ws + WS_QH) + row0 * HW + h * 64 + lane;
#endif
#pragma unroll
        for (int s = 0; s < 64; ++s) {
#if defined(HG_WIDE) && HG_WIDE
            const float qv = bf2f(*(const LAS unsigned short*)(qimg + s * 128 + lane * 2));
#else
            const float qv = bf2f(qp[(size_t)s * HW]);
#endif
            *(LAS unsigned short*)(qimg + s * 128 + lane * 2) = (unsigned short)cvt1_bf16(qv * __expf(bc[s] - bref));
            *(LAS unsigned short*)(kimg + s * 128 + lane * 2) = (unsigned short)cvt1_bf16(kf[s] * __expf(bref - bc[s]));
        }
    }
    const int r32 = lane & 31, hf = lane >> 5;
    bf16x8 qf[2][4];
#pragma unroll
    for (int tb = 0; tb < 2; ++tb)
#pragma unroll
        for (int ks = 0; ks < 4; ++ks) qf[tb][ks] = *(const LAS bf16x8*)(qimg + (32 * tb + r32) * 128 + hf * 64 + ks * 16);
    float zz = 0.f; asm volatile("" : "+v"(zz));
    f32x16 a00, a01, a11;
#pragma unroll
    for (int i = 0; i < 16; ++i) { a00[i] = zz; a01[i] = zz; a11[i] = zz; }
#pragma unroll
    for (int ks = 0; ks < 4; ++ks) {
        const bf16x8 k0 = *(const LAS bf16x8*)(kimg + r32 * 128 + hf * 64 + ks * 16), k1 = *(const LAS bf16x8*)(kimg + (32 + r32) * 128 + hf * 64 + ks * 16);
        a00 = __builtin_amdgcn_mfma_f32_32x32x16_bf16(k0, qf[0][ks], a00, 0, 0, 0);
        a01 = __builtin_amdgcn_mfma_f32_32x32x16_bf16(k0, qf[1][ks], a01, 0, 0, 0);
        a11 = __builtin_amdgcn_mfma_f32_32x32x16_bf16(k1, qf[1][ks], a11, 0, 0, 0);
    }
#pragma unroll
    for (int i = 0; i < 16; ++i) { const int sl = (i & 3) + 8 * (i >> 2) + 4 * hf; if (sl > r32) { a00[i] = zz; a11[i] = zz; } }
    f32x16 o[2][2];
#pragma unroll
    for (int a = 0; a < 2; ++a)
#pragma unroll
        for (int c = 0; c < 2; ++c)
#pragma unroll
            for (int i = 0; i < 16; ++i) o[a][c][i] = zz;
    const bf16_t* sp = (const bf16_t*)(F.ws + WS_SLOC) + (size_t)u * 4096;
#pragma unroll
    for (int db = 0; db < 2; ++db)
#pragma unroll
        for (int ks = 0; ks < 4; ++ks) {
            const bf16x8 sf = *(const GAS bf16x8*)(sp + (32 * db + r32) * 64 + 32 * hf + 8 * ks);
            o[db][0] = __builtin_amdgcn_mfma_f32_32x32x16_bf16(sf, qf[0][ks], o[db][0], 0, 0, 0);
            o[db][1] = __builtin_amdgcn_mfma_f32_32x32x16_bf16(sf, qf[1][ks], o[db][1], 0, 0, 0);
        }
    LAS unsigned char* vimg = qimg;
    hgrn_v_image((const bf16_t*)(F.ws + WS_IH), row0, h, lane, vimg);
    const int trb = (4 * hf + ((lane & 15) >> 2)) * 64 + (((lane >> 4) & 1) * 16 + (lane & 3) * 4) * 2;
#pragma unroll
    for (int s2 = 0; s2 < 2; ++s2) {
        u32x4 w;
        w.x = cvt_pk_bf16(a00[8 * s2 + 0], a00[8 * s2 + 1]); w.y = cvt_pk_bf16(a00[8 * s2 + 2], a00[8 * s2 + 3]); w.z = cvt_pk_bf16(a00[8 * s2 + 4], a00[8 * s2 + 5]); w.w = cvt_pk_bf16(a00[8 * s2 + 6], a00[8 * s2 + 7]);
        const bf16x8 p00 = __builtin_bit_cast(bf16x8, w);
        w.x = cvt_pk_bf16(a01[8 * s2 + 0], a01[8 * s2 + 1]); w.y = cvt_pk_bf16(a01[8 * s2 + 2], a01[8 * s2 + 3]); w.z = cvt_pk_bf16(a01[8 * s2 + 4], a01[8 * s2 + 5]); w.w = cvt_pk_bf16(a01[8 * s2 + 6], a01[8 * s2 + 7]);
        const bf16x8 p01 = __builtin_bit_cast(bf16x8, w);
        w.x = cvt_pk_bf16(a11[8 * s2 + 0], a11[8 * s2 + 1]); w.y = cvt_pk_bf16(a11[8 * s2 + 2], a11[8 * s2 + 3]); w.z = cvt_pk_bf16(a11[8 * s2 + 4], a11[8 * s2 + 5]); w.w = cvt_pk_bf16(a11[8 * s2 + 6], a11[8 * s2 + 7]);
        const bf16x8 p11 = __builtin_bit_cast(bf16x8, w);
#pragma unroll
        for (int db = 0; db < 2; ++db) {
            const LAS unsigned char* t0 = vimg + db * 4096 + trb + (16 * s2) * 64;
            const bf16x8 v0 = cat4(vtr(t0), vtr(t0 + 512));
            const bf16x8 v1 = cat4(vtr(t0 + 2048), vtr(t0 + 2048 + 512));
            o[db][0] = __builtin_amdgcn_mfma_f32_32x32x16_bf16(v0, p00, o[db][0], 0, 0, 0);
            o[db][1] = __builtin_amdgcn_mfma_f32_32x32x16_bf16(v0, p01, o[db][1], 0, 0, 0);
            o[db][1] = __builtin_amdgcn_mfma_f32_32x32x16_bf16(v1, p11, o[db][1], 0, 0, 0);
        }
    }
#if defined(BR_FP8) && (BR_FP8 & 2)
    unsigned char* rp = (unsigned char*)(F.ws + WS_REC);
#pragma unroll
    for (int tb = 0; tb < 2; ++tb) { unsigned char* op = rp + (row0 + 32 * tb + r32) * HW + h * 64 + 4 * hf;
#pragma unroll
        for (int db = 0; db < 2; ++db)
#pragma unroll
            for (int c = 0; c < 4; ++c) { int w = __builtin_amdgcn_cvt_pk_fp8_f32(F8SAT(o[db][tb][4 * c]), F8SAT(o[db][tb][4 * c + 1]), 0, false); w = __builtin_amdgcn_cvt_pk_fp8_f32(F8SAT(o[db][tb][4 * c + 2]), F8SAT(o[db][tb][4 * c + 3]), w, true); *(GAS int*)(op + 32 * db + 8 * c) = w; } }
#else
    bf16_t* rp = (bf16_t*)(F.ws + WS_REC);
#pragma unroll
    for (int tb = 0; tb < 2; ++tb) { bf16_t* op = rp + (row0 + 32 * tb + r32) * HW + h * 64 + 4 * hf;
#pragma unroll
        for (int db = 0; db < 2; ++db)
#pragma unroll
            for (int c = 0; c < 4; ++c) { u32x2 w; w.x = cvt_pk_bf16(o[db][tb][4 * c], o[db][tb][4 * c + 1]); w.y = cvt_pk_bf16(o[db][tb][4 * c + 2], o[db][tb][4 * c + 3]); *(GAS u32x2*)(op + 32 * db + 8 * c) = w; } }
#endif
}
__device__ __forceinline__ void hgrn_out_phase(const Frame& F) {
    const int gw = F.vcu * NWAVES + F.wave, NGW = F.G * NWAVES;
    for (int u = gw; u < NB * 128 * NH; u += NGW) hgrn_out(F, u);
}
__device__ __forceinline__ void merge_phase(const Frame& F, const float* attn_norm_l, const float* hgrn_norm_l) {
    const bf16_t* PART = (const bf16_t*)(F.ws + WS_PART); const float* LSE = (const float*)(F.ws + WS_LSE);
    const bf16_t* REC = (const bf16_t*)(F.ws + WS_REC); const bf16_t* OG = (const bf16_t*)(F.ws + WS_OG); bf16_t* HB = (bf16_t*)(F.ws + WS_HB);
    const int gw = F.vcu * NWAVES + F.wave, NGW = F.G * NWAVES, lane = F.lane, hd = lane >> 3;
    const f32x4 an0 = *(const GAS f32x4*)(attn_norm_l + lane * 8), an1 = *(const GAS f32x4*)(attn_norm_l + lane * 8 + 4);
    const f32x4 hn0 = *(const GAS f32x4*)(hgrn_norm_l + lane * 8), hn1 = *(const GAS f32x4*)(hgrn_norm_l + lane * 8 + 4);
    if (gw >= T) return;
#if defined(BR_FP8) && (BR_FP8 & 1)
    typedef u32x2 mrg_p_t;
#define MRG_PLD(base_, rw_) (*(const GAS u32x2*)((const GAS unsigned char*)PART + (base_) + (size_t)(rw_) * AW + lane * 8))
#else
    typedef u32x4 mrg_p_t;
#define MRG_PLD(base_, rw_) (*(const GAS u32x4*)(PART + (base_) + (size_t)(rw_) * AW + lane * 8))
#endif
#if defined(BR_FP8) && (BR_FP8 & 2)
    typedef u32x2 mrg_r_t;
#define MRG_RLD(rw_) (*(const GAS u32x2*)((const GAS unsigned char*)REC + (size_t)(rw_) * HW + lane * 8))
#else
    typedef u32x4 mrg_r_t;
#define MRG_RLD(rw_) (*(const GAS u32x4*)(REC + (size_t)(rw_) * HW + lane * 8))
#endif
#if defined(OG_U8) && OG_U8
    typedef u32x2 mrg_g_t;
#define MRG_GLD(rw_) (*(const GAS u32x2*)((const GAS unsigned char*)OG + (size_t)(rw_) * HW + lane * 8))
#else
    typedef u32x4 mrg_g_t;
#define MRG_GLD(rw_) (*(const GAS u32x4*)(OG + (size_t)(rw_) * HW + lane * 8))
#endif
    mrg_p_t n0, n1, n2; mrg_r_t nr; mrg_g_t ng; float nl0, nl1, nl2;
#define MRG_LOAD(rw) do { nl0 = ((const GAS float*)LSE)[(size_t)(rw) * NH + hd]; nl1 = ((const GAS float*)LSE)[(size_t)T * NH + (size_t)(rw) * NH + hd]; nl2 = ((const GAS float*)LSE)[(size_t)2 * T * NH + (size_t)(rw) * NH + hd]; \
        n0 = MRG_PLD((size_t)0, rw); n1 = MRG_PLD((size_t)T * AW, rw); n2 = MRG_PLD((size_t)2 * T * AW, rw); nr = MRG_RLD(rw); ng = MRG_GLD(rw); } while (0)
#define MRG_UNP8(o_, w_) do { o_[0] = __builtin_amdgcn_cvt_f32_fp8((int)(w_).x, 0); o_[1] = __builtin_amdgcn_cvt_f32_fp8((int)(w_).x, 1); o_[2] = __builtin_amdgcn_cvt_f32_fp8((int)(w_).x, 2); o_[3] = __builtin_amdgcn_cvt_f32_fp8((int)(w_).x, 3); \
        o_[4] = __builtin_amdgcn_cvt_f32_fp8((int)(w_).y, 0); o_[5] = __builtin_amdgcn_cvt_f32_fp8((int)(w_).y, 1); o_[6] = __builtin_amdgcn_cvt_f32_fp8((int)(w_).y, 2); o_[7] = __builtin_amdgcn_cvt_f32_fp8((int)(w_).y, 3); } while (0)
#define MRG_UNP16(o_, w_) do { _Pragma("unroll") for (int j_ = 0; j_ < 4; ++j_) { o_[2 * j_] = bflo((w_)[j_]); o_[2 * j_ + 1] = bfhi((w_)[j_]); } } while (0)
#if defined(BR_FP8) && (BR_FP8 & 1)
#define MRG_UNPP MRG_UNP8
#else
#define MRG_UNPP MRG_UNP16
#endif
#if defined(BR_FP8) && (BR_FP8 & 2)
#define MRG_UNPR MRG_UNP8
#else
#define MRG_UNPR MRG_UNP16
#endif
    MRG_LOAD(gw);
#pragma unroll 1
    for (int row = gw; row < T; row += NGW) {
        const float l0 = nl0, l1 = nl1, l2 = nl2; const mrg_p_t p0 = n0, p1 = n1, p2 = n2; const mrg_r_t rr = nr; const mrg_g_t gg = ng;
        { const int nrow = (row + NGW < T) ? row + NGW : row; MRG_LOAD(nrow); }
        const float lm = fmaxf(l0, fmaxf(l1, l2));
        float w0 = __builtin_amdgcn_exp2f(l0 - lm), w1 = __builtin_amdgcn_exp2f(l1 - lm), w2 = __builtin_amdgcn_exp2f(l2 - lm);
        const float wi = __builtin_amdgcn_rcpf(w0 + w1 + w2); w0 *= wi; w1 *= wi; w2 *= wi;
        float a[8], r[8], g[8]; float sa = 0.f, sr = 0.f;
        float q0[8], q1[8], q2[8];
        MRG_UNPP(q0, p0); MRG_UNPP(q1, p1); MRG_UNPP(q2, p2); MRG_UNPR(r, rr);
#pragma unroll
        for (int j = 0; j < 4; ++j) {
            a[2 * j] = w0 * q0[2 * j] + w1 * q1[2 * j] + w2 * q2[2 * j]; a[2 * j + 1] = w0 * q0[2 * j + 1] + w1 * q1[2 * j + 1] + w2 * q2[2 * j + 1];
#if defined(OG_U8) && OG_U8
            { const unsigned gw_ = (j < 2) ? gg.x : gg.y; const int sh_ = 16 * (j & 1);
              g[2 * j] = (float)((gw_ >> sh_) & 0xffu) * (1.0f / 255.0f); g[2 * j + 1] = (float)((gw_ >> (sh_ + 8)) & 0xffu) * (1.0f / 255.0f); }
#elif defined(SIG_IN_MN) && SIG_IN_MN
            g[2 * j] = sigm_f(bflo(gg[j])); g[2 * j + 1] = sigm_f(bfhi(gg[j]));
#else
            g[2 * j] = bflo(gg[j]); g[2 * j + 1] = bfhi(gg[j]);
#endif
        }
#pragma unroll
        for (int j = 0; j < 8; ++j) { sa += a[j] * a[j]; sr += r[j] * r[j]; }
        const float ra = __builtin_amdgcn_rsqf(wave_sum(sa) * (1.f / AW) + EPS), rq = __builtin_amdgcn_rsqf(wave_sum(sr) * (1.f / HW) + EPS);
        u32x4 oa, orr;
        oa.x = pk2(a[0] * ra * an0[0], a[1] * ra * an0[1]); oa.y = pk2(a[2] * ra * an0[2], a[3] * ra * an0[3]); oa.z = pk2(a[4] * ra * an1[0], a[5] * ra * an1[1]); oa.w = pk2(a[6] * ra * an1[2], a[7] * ra * an1[3]);
        orr.x = pk2(r[0] * rq * hn0[0] * g[0], r[1] * rq * hn0[1] * g[1]); orr.y = pk2(r[2] * rq * hn0[2] * g[2], r[3] * rq * hn0[3] * g[3]);
        orr.z = pk2(r[4] * rq * hn1[0] * g[4], r[5] * rq * hn1[1] * g[5]); orr.w = pk2(r[6] * rq * hn1[2] * g[6], r[7] * rq * hn1[3] * g[7]);
        *(GAS u32x4*)(HB + (size_t)row * D + lane * 8) = oa; *(GAS u32x4*)(HB + (size_t)row * D + AW + lane * 8) = orr;
    }
#undef MRG_LOAD
}
__device__ __forceinline__ void bf8_to_f32(u32x4 w, f32x4& lo, f32x4& hi) { lo = (f32x4){bflo(w.x), bfhi(w.x), bflo(w.y), bfhi(w.y)}; hi = (f32x4){bflo(w.z), bfhi(w.z), bflo(w.w), bfhi(w.w)}; }
#if defined(EPI_HOIST) && (EPI_HOIST & 1)
template <bool SRC_F32>
#endif
struct EpiOut {
    static constexpr bool PROBE2 = false;
    static constexpr bool PERM = true;
#if defined(OUT16) && OUT16
    static constexpr bool PERM16 = true;
#define EPO_CB 8
#define EPO_C0(wc_, fq_) ((wc_) * 64 + 16 * (fq_))
#else
    static constexpr bool PERM16 = false;
#define EPO_CB HALF
#define EPO_C0(wc_, fq_) ((wc_) * 32 + 8 * (fq_))
#endif
    const float* xf; const bf16_t* xb; bf16_t* xout; const float* g1; bool src_f32; WtBuf wt;
    __device__ __forceinline__ void operator()(const f32x4 (&acc)[2][2][4][2], const GUnit& u, int wr, int wc, int fr, int fq) const {
        const int row0 = u.pm * BM + wr * 64 + fr, col0 = u.pn * BM + EPO_C0(wc, fq), b = (u.pm * BM) / S;
        f32x4 gv[2][2];
#pragma unroll
        for (int bj = 0; bj < 2; ++bj)
#pragma unroll
            for (int n = 0; n < 2; ++n) gv[bj][n] = *(const GAS f32x4*)(g1 + (size_t)b * 6 * D + col0 + bj * EPO_CB + 4 * n);
#if defined(EPI_HOIST) && (EPI_HOIST & 1)
#define EPO_STORES() do { _Pragma("unroll") for (int ai = 0; ai < 2; ++ai) _Pragma("unroll") for (int m = 0; m < 4; ++m) _Pragma("unroll") for (int bj = 0; bj < 2; ++bj) \
            st8w(wt, xout + (size_t)(row0 + ai * HALF + m * 16) * D + col0 + bj * EPO_CB, o[ai][bj][m][0], o[ai][bj][m][1]); } while (0)
        if (SRC_F32) {
            f32x4 o[2][2][4][2];
#pragma unroll
            for (int q = 0; q < 4; ++q) { const int ai = q >> 1, mb = (q & 1) * 2;
                f32x4 xr[2][2][2];
#pragma unroll
                for (int mm = 0; mm < 2; ++mm)
#pragma unroll
                    for (int bj = 0; bj < 2; ++bj) { const size_t o_ = (size_t)(row0 + ai * HALF + (mb + mm) * 16) * D + col0 + bj * EPO_CB; xr[mm][bj][0] = *(const GAS f32x4*)(xf + o_); xr[mm][bj][1] = *(const GAS f32x4*)(xf + o_ + 4); }
#pragma unroll
                for (int mm = 0; mm < 2; ++mm)
#pragma unroll
                    for (int bj = 0; bj < 2; ++bj)
#pragma unroll
                        for (int n = 0; n < 2; ++n) o[ai][bj][mb + mm][n] = xr[mm][bj][n] + gv[bj][n] * acc[ai][bj][mb + mm][n];
                asm volatile("" ::: "memory"); __builtin_amdgcn_sched_barrier(0);
            }
            EPO_STORES();
        } else {
            f32x4 o[2][2][4][2];
#pragma unroll
            for (int ai = 0; ai < 2; ++ai) {
                u32x4 xr[4][2];
#pragma unroll
                for (int m = 0; m < 4; ++m)
#pragma unroll
                    for (int bj = 0; bj < 2; ++bj) xr[m][bj] = *(const GAS u32x4*)(xb + (size_t)(row0 + ai * HALF + m * 16) * D + col0 + bj * EPO_CB);
#pragma unroll
                for (int m = 0; m < 4; ++m)
#pragma unroll
                    for (int bj = 0; bj < 2; ++bj) { f32x4 x0, x1; bf8_to_f32(xr[m][bj], x0, x1); o[ai][bj][m][0] = x0 + gv[bj][0] * acc[ai][bj][m][0]; o[ai][bj][m][1] = x1 + gv[bj][1] * acc[ai][bj][m][1]; }
                asm volatile("" ::: "memory"); __builtin_amdgcn_sched_barrier(0);
            }
            EPO_STORES();
        }
#undef EPO_STORES
#else
        f32x4 xn[2][2];
#define EPO_LOAD(rw) do { _Pragma("unroll") for (int bj_ = 0; bj_ < 2; ++bj_) { const size_t o_ = (size_t)(rw) * D + col0 + bj_ * EPO_CB; \
            if (src_f32) { xn[bj_][0] = *(const GAS f32x4*)(xf + o_); xn[bj_][1] = *(const GAS f32x4*)(xf + o_ + 4); } else { bf8_to_f32(*(const GAS u32x4*)(xb + o_), xn[bj_][0], xn[bj_][1]); } } } while (0)
        EPO_LOAD(row0);
#pragma unroll
        for (int g = 0; g < 8; ++g) { const int ai = g >> 2, m = g & 3, row = row0 + ai * HALF + m * 16;
            f32x4 xc[2][2];
#pragma unroll
            for (int bj = 0; bj < 2; ++bj)
#pragma unroll
                for (int n = 0; n < 2; ++n) xc[bj][n] = xn[bj][n];
            if (g < 7) { const int r2 = row0 + ((g + 1) >> 2) * HALF + ((g + 1) & 3) * 16; EPO_LOAD(r2); }
#pragma unroll
            for (int bj = 0; bj < 2; ++bj) st8w(wt, xout + (size_t)row * D + col0 + bj * EPO_CB, xc[bj][0] + gv[bj][0] * acc[ai][bj][m][0], xc[bj][1] + gv[bj][1] * acc[ai][bj][m][1]);
        }
#undef EPO_LOAD
#endif
    }
};

__device__ __forceinline__ void route_lane(const float (&lgs)[NE], LAS int* lcnt, LAS int* sel, int lrow) {
    float mx = lgs[0];
#pragma unroll
    for (int e = 1; e < NE; ++e) mx = fmaxf(mx, lgs[e]);
    float pr[NE];
#pragma unroll
    for (int e = 0; e < NE; ++e) pr[e] = __expf(lgs[e] - mx);
    int gs = 0, i1 = 0, i2 = 0; float best = -1.f, v1 = 0.f, v2 = 0.f;
#pragma unroll
    for (int g = 0; g < 4; ++g) { float m1 = -1.f, m2 = -1.f; int j1 = 0, j2 = 0;
#pragma unroll
        for (int i = 0; i < 4; ++i) { const float pv = pr[g * 4 + i]; if (pv > m1) { m2 = m1; j2 = j1; m1 = pv; j1 = i; } else if (pv > m2) { m2 = pv; j2 = i; } }
        const float sg = m1 + m2; if (sg > best) { best = sg; gs = g; v1 = m1; v2 = m2; i1 = j1; i2 = j2; } }
    const float wsum = v1 + v2; const int e1 = gs * 4 + i1, e2 = gs * 4 + i2;
    const int p1 = atomicAdd((int*)(lcnt + e1), 1), p2 = atomicAdd((int*)(lcnt + e2), 1);
    sel[lrow * 4 + 0] = e1 | (e2 << 8) | (p1 << 16) | (p2 << 24); sel[lrow * 4 + 1] = __builtin_bit_cast(int, v1 / wsum); sel[lrow * 4 + 2] = __builtin_bit_cast(int, v2 / wsum);
}
constexpr int RT_HSTR = 1028;
constexpr int RT_HS = 0, RT_PART = 16 * RT_HSTR * 4, RT_SEL = RT_PART + 8 * 256 * 4, RT_LCNT = RT_SEL + 64 * 16, RT_END = RT_LCNT + 64;
static_assert(RT_END <= RING_BYTES, "router LDS map");
__device__ __forceinline__ void router_phase(const Frame& F, const bf16_t* x1, const float* mod_l, const float* w_router, const float* b_router, int layer, bool junk = false) {
    LAS float* Hs = (LAS float*)(F.lds + RING_OFF + RT_HS);
    LAS float* Pp = (LAS float*)(F.lds + RING_OFF + RT_PART);
    LAS int* sel = (LAS int*)(F.lds + RING_OFF + RT_SEL);
    LAS int* lcnt = (LAS int*)(F.lds + RING_OFF + RT_LCNT);
    bf16_t* HB = (bf16_t*)(F.ws + WS_HB); int* cntb = (int*)(F.ws + (junk ? WS_PART : WS_CNTB)); int* selg = (int*)(F.ws + (junk ? WS_PART + 2 * MiB : WS_SELG));
    const int lane = F.lane, w = F.wave, fr = lane & 15, fq = lane >> 4;
    float breg[32];
#pragma unroll
    for (int ks = 0; ks < 32; ++ks) breg[ks] = ((const GAS float*)w_router)[(size_t)(128 * w + 4 * ks + fq) * NE + fr];
    const float bias = ((const GAS float*)b_router)[fr];
    for (int blk = F.vcu; blk < T / 64; blk += F.G) {
        if (F.tid < 16) lcnt[F.tid] = 0;
        const float* m = mod_l + (size_t)((blk * 64) / S) * 6 * D + 3 * D;
        f32x4 shv[4], scv[4];
#pragma unroll
        for (int j = 0; j < 2; ++j) { const int k0 = 8 * lane + 512 * j;
            shv[2 * j] = *(const GAS f32x4*)(m + k0); shv[2 * j + 1] = *(const GAS f32x4*)(m + k0 + 4); scv[2 * j] = *(const GAS f32x4*)(m + D + k0) + 1.0f; scv[2 * j + 1] = *(const GAS f32x4*)(m + D + k0 + 4) + 1.0f; }
        u32x4 vn[2][2];
        { const GAS u32x4* xr = (const GAS u32x4*)(x1 + (size_t)(blk * 64 + 2 * w) * D) + lane; vn[0][0] = xr[0]; vn[0][1] = xr[64]; vn[1][0] = xr[128]; vn[1][1] = xr[192]; }
#pragma unroll 1
        for (int q = 0; q < 4; ++q) {
            u32x4 vc[2][2];
#pragma unroll
            for (int i = 0; i < 2; ++i) { vc[i][0] = vn[i][0]; vc[i][1] = vn[i][1]; }
            { const int nq = q < 3 ? q + 1 : q; const GAS u32x4* xr = (const GAS u32x4*)(x1 + (size_t)(blk * 64 + 16 * nq + 2 * w) * D) + lane; vn[0][0] = xr[0]; vn[0][1] = xr[64]; vn[1][0] = xr[128]; vn[1][1] = xr[192]; }
#pragma unroll
            for (int i = 0; i < 2; ++i) {
                const int hr = 2 * w + i, row = blk * 64 + 16 * q + hr;
                f32x4 v[4];
                bf8_to_f32(vc[i][0], v[0], v[1]); bf8_to_f32(vc[i][1], v[2], v[3]);
                float ss = 0.f;
#pragma unroll
                for (int j = 0; j < 4; ++j) ss += (v[j].x * v[j].x + v[j].y * v[j].y) + (v[j].z * v[j].z + v[j].w * v[j].w);
                const float r = 1.0f / sqrtf(wave_sum(ss) * (1.f / D) + EPS);
                GAS u32x4* o8 = (GAS u32x4*)(HB + (size_t)row * D) + lane;
#pragma unroll
                for (int j = 0; j < 2; ++j) {
                    const f32x4 h0 = v[2 * j] * r * scv[2 * j] + shv[2 * j], h1 = v[2 * j + 1] * r * scv[2 * j + 1] + shv[2 * j + 1];
                    u32x4 w8; w8.x = pk2(h0.x, h0.y); w8.y = pk2(h0.z, h0.w); w8.z = pk2(h1.x, h1.y); w8.w = pk2(h1.z, h1.w); o8[64 * j] = w8;
                    LAS float* hp = Hs + hr * RT_HSTR + 8 * lane + 512 * j; *(LAS f32x4*)hp = h0; *(LAS f32x4*)(hp + 4) = h1;
                }
            }
            __syncthreads();
            f32x4 acc = (f32x4){0.f, 0.f, 0.f, 0.f};
            { const LAS float* ap = Hs + fr * RT_HSTR + 128 * w + fq;
#pragma unroll
              for (int ks = 0; ks < 32; ++ks) acc = __builtin_amdgcn_mfma_f32_16x16x4f32(ap[4 * ks], breg[ks], acc, 0, 0, 0); }
#pragma unroll
            for (int i = 0; i < 4; ++i) Pp[w * 256 + (4 * fq + i) * 16 + fr] = acc[i];
            __syncthreads();
            if (w == 0) {
                float lgs[NE];
                if (lane < 16) {
#pragma unroll
                    for (int e = 0; e < NE; ++e) { float s = 0.f;
#pragma unroll
                        for (int ww = 0; ww < 8; ++ww) s += Pp[ww * 256 + lane * 16 + e];
                        lgs[e] = s + __builtin_bit_cast(float, __builtin_amdgcn_readlane(__builtin_bit_cast(int, bias), e)); }
                    route_lane(lgs, lcnt, sel, 16 * q + lane);
                }
            }
        }
        __syncthreads();
        if (F.tid < 16) ((GAS int*)cntb)[blk * 16 + F.tid] = lcnt[F.tid];
        if (F.tid < 64) { ((GAS int*)selg)[(blk * 64 + F.tid) * 4 + 0] = sel[F.tid * 4 + 0]; ((GAS int*)selg)[(blk * 64 + F.tid) * 4 + 1] = sel[F.tid * 4 + 1]; ((GAS int*)selg)[(blk * 64 + F.tid) * 4 + 2] = sel[F.tid * 4 + 2]; }
        __syncthreads();
    }
    __syncthreads();
}
__device__ __forceinline__ void scatter_phase(const Frame& F, int layer) {
    LAS int* cl = (LAS int*)(F.lds + RING_OFF);
    LAS int* part = cl + 256 * 16;
    LAS int* lbase = part + 256;
    const int* cntb = (const int*)(F.ws + WS_CNTB); const int* selg = (const int*)(F.ws + WS_SELG);
    int* list = (int*)(F.ws + WS_LIST); float* pw = (float*)(F.ws + WS_PW); unsigned* cnt = (unsigned*)(F.ctl + CW_CNT + layer * 1024);
    {   int t[8];
#pragma unroll
        for (int j = 0; j < 8; ++j) t[j] = cntb[F.tid + NTHR * j];
#pragma unroll
        for (int j = 0; j < 8; ++j) cl[F.tid + NTHR * j] = t[j]; }
    __syncthreads();
    if (F.tid < 256) { const int e = F.tid & 15, ch = F.tid >> 4; int s = 0;
#pragma unroll
        for (int j = 0; j < 16; ++j) s += cl[(ch * 16 + j) * 16 + e];
        part[ch * 16 + e] = s; }
    __syncthreads();
    for (int blk = F.vcu; blk < T / 64; blk += F.G) {
        if (F.tid < 16) { const int e = F.tid; int run = 0;
            for (int ch = 0; ch < 16; ++ch) { if (ch == (blk >> 4)) { int b2 = run; for (int j = 0; j < (blk & 15); ++j) b2 += cl[((blk & ~15) + j) * 16 + e]; lbase[e] = b2; } run += part[ch * 16 + e]; }
            if (blk == 0) cnt[64 * e] = (unsigned)run; }
        __syncthreads();
        if (F.tid < 128) { const int lrow = F.tid >> 1, slot = F.tid & 1, row = blk * 64 + lrow; const int pk = selg[(blk * 64 + lrow) * 4];
            const int e = (pk >> (8 * slot)) & 0xff, lp = (pk >> (16 + 8 * slot)) & 0xff; const size_t at = (size_t)e * T + lbase[e] + lp;
            list[at] = row * 2 + slot; pw[at] = __builtin_bit_cast(float, selg[(blk * 64 + lrow) * 4 + 1 + slot]); }
        __syncthreads();
    }
    __syncthreads();
}

template <int MODE> struct MoeOrder {
    static constexpr int mode = MODE; static constexpr bool gather = (MODE == 0);
    const char* A; const char* Bt; const unsigned* cnt; const int* list; int K, G, c; size_t bstride; unsigned* ready; unsigned* tmo;
#if defined(CNT_CACHE) && CNT_CACHE
    int cjs[NE];
    __device__ __forceinline__ void load_counts() {
#pragma unroll
        for (int j = 0; j < NE; ++j) cjs[j] = (int)__builtin_amdgcn_readfirstlane(__hip_atomic_load((const GAS unsigned*)cnt + 64 * j, __ATOMIC_RELAXED, __HIP_MEMORY_SCOPE_AGENT)); }
#define MOE_CJ(j) cjs[j]
#else
    __device__ __forceinline__ void load_counts() {}
#define MOE_CJ(j) ((int)__builtin_amdgcn_readfirstlane(__hip_atomic_load((const GAS unsigned*)cnt + 64 * (j), __ATOMIC_RELAXED, __HIP_MEMORY_SCOPE_AGENT)))
#endif
    __device__ __forceinline__ int total_units() const { int t = 0;
#pragma unroll
        for (int j = 0; j < NE; ++j) { const int cj = MOE_CJ(j); t += (cj + 255) >> 8; }
        return 4 * t; }
    __device__ __forceinline__ int deal(int i, int U) const {
        const int t = U - 2 * G;
        if (G != 256 || t <= 0 || t > 51) { const int L = i * G + c; return L < U ? L : -1; }
        const int a = 3 * t, b = G - 5 * t;
        if (mode == 0) {
            if (i == 0) return c;
            if (i == 1) return c < a + b ? G + c : -1;
            if (i == 2) return c < a ? G + a + b + c : -1;
            return -1;
        }
        if (c < a) return i == 0 ? 2 * G - 2 * t + c : -1;
        if (c < a + b) return i < 2 ? 8 * t + i * b + (c - a) : -1;
        return i < 4 ? i * 2 * t + (c - a - b) : -1;
    }
    __device__ __forceinline__ bool next(int i, GUnit& u) const {
        int tt = 0;
        int e = -1, tb = 0, ro = 0, ce = 0, tacc = 0, racc = 0;
#pragma unroll
        for (int j = 0; j < NE; ++j) { const int cj = MOE_CJ(j); tt += (cj + 255) >> 8; }
        const int L = deal(i, 4 * tt);
        if (L < 0) return false;
        const int rt = L >> 2;
#pragma unroll
        for (int j = 0; j < NE; ++j) { const int cj = MOE_CJ(j); const int tj = (cj + 255) >> 8;
            if (rt >= tacc && rt < tacc + tj) { e = j; tb = tacc; ro = racc; ce = cj; } tacc += tj; racc += cj; }
        if (e < 0) return false;
        u.e = e; u.row0 = (rt - tb) * BM; u.nrows = (ce - u.row0) < BM ? (ce - u.row0) : BM; u.pm = ro + u.row0; u.pn = L & 3; u.rtg = rt;
        u.B = Bt + (size_t)e * bstride + (size_t)u.pn * BM * K * 2;
        u.A = gather ? A : A + (size_t)u.pm * K * 2;
        return true;
    }
    __device__ __forceinline__ int arow(const GUnit& u, int r) const { const unsigned rr = r < u.nrows ? (unsigned)r : 0u; const GAS int* lp = (const GAS int*)list + ((size_t)u.e * T + u.row0); return lp[rr] >> 1; }
    struct Early { unsigned pv; int ok, pending; };
    __device__ __forceinline__ void early_reset(Early& st) const { st.pv = 0u; st.ok = 0; st.pending = 0; }
    __device__ __forceinline__ void a_early(const GUnit& u, Early& st) const {
#if defined(EARLY_ACQ) && EARLY_ACQ
        if (mode == 0) return;
        if (__builtin_amdgcn_readfirstlane((int)(threadIdx.x >> 6)) == 0) {
            if (st.pending && !st.ok) { unsigned v; asm volatile("v_readfirstlane_b32 %0, %1" : "=s"(v) : "v"(st.pv)); if (v >= 32u) { asm volatile("buffer_inv sc1" ::: "memory"); st.ok = 1; } }
            if (!st.ok) { const GAS unsigned* rp = (const GAS unsigned*)ready + 64 * u.rtg; asm volatile("global_load_dword %0, %1, off sc1" : "=v"(st.pv) : "v"(rp) : "memory"); st.pending = 1; }
        }
#endif
    }
    __device__ __forceinline__ void a_ready(const GUnit& u0, int idx, Early& st) const {
        if (mode == 0) return;
#if defined(EARLY_ACQ) && EARLY_ACQ
        const bool done = st.ok != 0; early_reset(st);
        if (done) { asm volatile("" ::: "memory"); __builtin_amdgcn_s_barrier(); asm volatile("" ::: "memory"); return; }
#endif
#if defined(ACQ_ONCE) && ACQ_ONCE
        if (idx > 0) return;
#endif
        if (threadIdx.x < 64) {
            unsigned polls = 0;
#if defined(ACQ_ONCE) && ACQ_ONCE
            for (int i = 0; i < 6; ++i) { GUnit u; if (!next(i, u)) break;
#else
            { const GUnit& u = u0;
#endif
            while ((unsigned)__builtin_amdgcn_readfirstlane(__hip_atomic_load((const GAS unsigned*)ready + 64 * u.rtg, __ATOMIC_RELAXED, __HIP_MEMORY_SCOPE_AGENT)) < 32u) {
                if ((++polls & 255u) == 0u) { if (__builtin_amdgcn_readfirstlane(__hip_atomic_load(tmo, __ATOMIC_RELAXED, __HIP_MEMORY_SCOPE_AGENT)) != 0u) break;
                    if (polls > (1u << 20)) { if (threadIdx.x == 0) __hip_atomic_store(tmo, 1u, __ATOMIC_RELAXED, __HIP_MEMORY_SCOPE_AGENT); break; } }
                __builtin_amdgcn_s_sleep(2); }
            }
            __builtin_amdgcn_fence(__ATOMIC_ACQUIRE, "agent");
            asm volatile("s_waitcnt vmcnt(0)" ::: "memory");
        }
        asm volatile("" ::: "memory"); __builtin_amdgcn_s_barrier(); asm volatile("" ::: "memory");
    }
};
struct EpiGateUp {
    static constexpr bool PROBE2 = false;
    static constexpr bool PERM = true;
    static constexpr bool PERM16 = false;
    bf16_t* H; unsigned* ready; WtBuf wt;
    __device__ __forceinline__ void operator()(const f32x4 (&acc)[2][2][4][2], const GUnit& u, int wr, int wc, int fr_, int fq_) const {
        const int fr = opqv(fr_), fq = opqv(fq_);
#pragma unroll
        for (int ai = 0; ai < 2; ++ai)
#pragma unroll
            for (int m = 0; m < 4; ++m) { const int r = ai * HALF + wr * 64 + m * 16 + fr;
                if (r < u.nrows) { f32x4 h0, h1;
#pragma unroll
                    for (int k = 0; k < 4; ++k) { h0[k] = silu_f(acc[ai][0][m][0][k]) * acc[ai][1][m][0][k]; h1[k] = silu_f(acc[ai][0][m][1][k]) * acc[ai][1][m][1][k]; }
                    u32x4 hv; hv.x = cvt_pk_bf16(h0[0], h0[1]); hv.y = cvt_pk_bf16(h0[2], h0[3]); hv.z = cvt_pk_bf16(h1[0], h1[1]); hv.w = cvt_pk_bf16(h1[2], h1[3]);
                    __builtin_amdgcn_raw_buffer_store_b128(hv, wt.rs, (int)(unsigned)((const unsigned char*)(H + (size_t)(u.pm + r) * FF + u.pn * HALF + wc * 32 + 8 * fq) - wt.base), 0, 16); } }
        asm volatile("s_waitcnt vmcnt(0)" ::: "memory");
        if (fr == 0 && fq == 0) __hip_atomic_fetch_add((GAS unsigned*)ready + 64 * u.rtg, 1u, __ATOMIC_RELAXED, __HIP_MEMORY_SCOPE_AGENT);
    }
};
struct EpiDown {
    static constexpr bool PROBE2 = false;
    static constexpr bool PERM = true;
#if defined(Y_FP8) && Y_FP8
    static constexpr bool PERM16 = true;
#else
    static constexpr bool PERM16 = false;
#endif
    bf16_t* Y; const int* list; const float* pw; WtBuf wt;
    __device__ __forceinline__ void operator()(const f32x4 (&acc)[2][2][4][2], const GUnit& u, int wr, int wc, int fr, int fq) const {
        int ent[8]; float wv[8];
#pragma unroll
        for (int g = 0; g < 8; ++g) { const int r = (g >> 2) * HALF + wr * 64 + (g & 3) * 16 + fr, rr = r < u.nrows ? r : 0;
            ent[g] = ((const GAS int*)list)[(size_t)u.e * T + u.row0 + rr]; wv[g] = ((const GAS float*)pw)[(size_t)u.e * T + u.row0 + rr]; }
#if defined(Y_FP8) && Y_FP8
        unsigned char* Y8 = (unsigned char*)Y;
#pragma unroll
        for (int g = 0; g < 8; ++g) { const int ai = g >> 2, m = g & 3, r = ai * HALF + wr * 64 + m * 16 + fr;
            if (r < u.nrows) { const float w = wv[g];
                unsigned char* yp = Y8 + ((size_t)(ent[g] & 1) * T + (ent[g] >> 1)) * D + u.pn * BM + wc * 64 + 16 * fq;
                u32x4 o;
#pragma unroll
                for (int q = 0; q < 4; ++q) { const f32x4 v = acc[ai][q >> 1][m][q & 1] * w; int d_ = __builtin_amdgcn_cvt_pk_fp8_f32(F8SAT(v[0]), F8SAT(v[1]), 0, false); d_ = __builtin_amdgcn_cvt_pk_fp8_f32(F8SAT(v[2]), F8SAT(v[3]), d_, true); o[q] = (unsigned)d_; }
                wt_store16(wt, yp, o); } }
#else
#pragma unroll
        for (int g = 0; g < 8; ++g) { const int ai = g >> 2, m = g & 3, r = ai * HALF + wr * 64 + m * 16 + fr;
            if (r < u.nrows) { const float w = wv[g];
                bf16_t* yp = Y + ((size_t)(ent[g] & 1) * T + (ent[g] >> 1)) * D + u.pn * BM + wc * 32 + 8 * fq;
#pragma unroll
                for (int bj = 0; bj < 2; ++bj) {
#if defined(Y_FP8_TEST)
                    f32x4 q0 = acc[ai][bj][m][0] * w, q1 = acc[ai][bj][m][1] * w;
                    { int a_ = __builtin_amdgcn_cvt_pk_fp8_f32(q0[0], q0[1], 0, false); a_ = __builtin_amdgcn_cvt_pk_fp8_f32(q0[2], q0[3], a_, true);
                      int b_ = __builtin_amdgcn_cvt_pk_fp8_f32(q1[0], q1[1], 0, false); b_ = __builtin_amdgcn_cvt_pk_fp8_f32(q1[2], q1[3], b_, true);
                      q0[0] = __builtin_amdgcn_cvt_f32_fp8(a_, 0); q0[1] = __builtin_amdgcn_cvt_f32_fp8(a_, 1); q0[2] = __builtin_amdgcn_cvt_f32_fp8(a_, 2); q0[3] = __builtin_amdgcn_cvt_f32_fp8(a_, 3);
                      q1[0] = __builtin_amdgcn_cvt_f32_fp8(b_, 0); q1[1] = __builtin_amdgcn_cvt_f32_fp8(b_, 1); q1[2] = __builtin_amdgcn_cvt_f32_fp8(b_, 2); q1[3] = __builtin_amdgcn_cvt_f32_fp8(b_, 3); }
                    st8w(wt, yp + bj * HALF, q0, q1);
#else
                    st8w(wt, yp + bj * HALF, acc[ai][bj][m][0] * w, acc[ai][bj][m][1] * w);
#endif
                } } }
#endif
    }
};
template <bool FINAL>
__device__ __forceinline__ void combine_phase(const Frame& F, float* outf, const float* g2  , const float* nmod  ) {
    const bf16_t* Y = (const bf16_t*)(F.ws + WS_Y); bf16_t* HB = (bf16_t*)(F.ws + WS_HB); bf16_t* XB = (bf16_t*)(F.ws + WS_XB);
    const int gw = F.vcu * NWAVES + F.wave, NGW = F.G * NWAVES, lane = F.lane;
    if (gw >= T) return;
#if defined(Y_FP8) && Y_FP8
    u32x4 xn[2]; u32x2 an[2], cn[2];
#define CMB_LOAD(rw) do { const GAS u32x4* xr_ = (const GAS u32x4*)(XB + (size_t)(rw) * D) + lane; const GAS u32x2* y0_ = (const GAS u32x2*)((const unsigned char*)Y + (size_t)(rw) * D) + lane; \
        const GAS u32x2* y1_ = (const GAS u32x2*)((const unsigned char*)Y + ((size_t)T + (rw)) * D) + lane; \
        xn[0] = xr_[0]; xn[1] = xr_[64]; an[0] = y0_[0]; an[1] = y0_[64]; cn[0] = y1_[0]; cn[1] = y1_[64]; } while (0)
#define CMB_Y(w_, lo_, hi_) do { lo_ = (f32x4){__builtin_amdgcn_cvt_f32_fp8((int)(w_).x, 0), __builtin_amdgcn_cvt_f32_fp8((int)(w_).x, 1), __builtin_amdgcn_cvt_f32_fp8((int)(w_).x, 2), __builtin_amdgcn_cvt_f32_fp8((int)(w_).x, 3)}; \
        hi_ = (f32x4){__builtin_amdgcn_cvt_f32_fp8((int)(w_).y, 0), __builtin_amdgcn_cvt_f32_fp8((int)(w_).y, 1), __builtin_amdgcn_cvt_f32_fp8((int)(w_).y, 2), __builtin_amdgcn_cvt_f32_fp8((int)(w_).y, 3)}; } while (0)
#else
    u32x4 xn[2], an[2], cn[2];
#define CMB_LOAD(rw) do { const GAS u32x4* xr_ = (const GAS u32x4*)(XB + (size_t)(rw) * D) + lane; const GAS u32x4* y0_ = (const GAS u32x4*)(Y + (size_t)(rw) * D) + lane; const GAS u32x4* y1_ = (const GAS u32x4*)(Y + ((size_t)T + (rw)) * D) + lane; \
        xn[0] = xr_[0]; xn[1] = xr_[64]; an[0] = y0_[0]; an[1] = y0_[64]; cn[0] = y1_[0]; cn[1] = y1_[64]; } while (0)
#define CMB_Y(w_, lo_, hi_) bf8_to_f32(w_, lo_, hi_)
#endif
    CMB_LOAD(gw);
#pragma unroll 1
    for (int row = gw; row < T; row += NGW) {
        const int b = row / S;
        f32x4 v[4]; float ss = 0.f;
        {   f32x4 x0, x1, x2, x3, a0, a1, a2, a3, c0, c1, c2, c3;
            bf8_to_f32(xn[0], x0, x1); bf8_to_f32(xn[1], x2, x3); CMB_Y(an[0], a0, a1); CMB_Y(an[1], a2, a3); CMB_Y(cn[0], c0, c1); CMB_Y(cn[1], c2, c3);
            { const int nrow = (row + NGW < T) ? row + NGW : row; CMB_LOAD(nrow); }
            const float* gp = g2 + (size_t)b * 6 * D + 8 * lane;
            v[0] = x0 + *(const GAS f32x4*)(gp) * (a0 + c0); v[1] = x1 + *(const GAS f32x4*)(gp + 4) * (a1 + c1); v[2] = x2 + *(const GAS f32x4*)(gp + 512) * (a2 + c2); v[3] = x3 + *(const GAS f32x4*)(gp + 516) * (a3 + c3); }
#pragma unroll
        for (int j = 0; j < 4; ++j) ss += (v[j].x * v[j].x + v[j].y * v[j].y) + (v[j].z * v[j].z + v[j].w * v[j].w);
        const float r = 1.0f / sqrtf(wave_sum(ss) * (1.f / D) + EPS);
        if (FINAL) {
            float* op = outf + (size_t)row * D + 8 * lane;
#pragma unroll
            for (int j = 0; j < 2; ++j) { const f32x4 f0 = *(const GAS f32x4*)(nmod + 8 * lane + 512 * j), f1 = *(const GAS f32x4*)(nmod + 8 * lane + 512 * j + 4);
                *(GAS f32x4*)(op + 512 * j) = v[2 * j] * r * f0; *(GAS f32x4*)(op + 512 * j + 4) = v[2 * j + 1] * r * f1; }
        } else {
            const float* m = nmod + (size_t)b * 6 * D + 8 * lane;
            GAS u32x4* xw = (GAS u32x4*)(XB + (size_t)row * D) + lane; GAS u32x4* o8 = (GAS u32x4*)(HB + (size_t)row * D) + lane;
#pragma unroll
            for (int j = 0; j < 2; ++j) { const f32x4 va = v[2 * j], vb = v[2 * j + 1];
                u32x4 wx; wx.x = pk2(va.x, va.y); wx.y = pk2(va.z, va.w); wx.z = pk2(vb.x, vb.y); wx.w = pk2(vb.z, vb.w); xw[64 * j] = wx;
                const f32x4 sh0 = *(const GAS f32x4*)(m + 512 * j), sh1 = *(const GAS f32x4*)(m + 512 * j + 4), sc0 = *(const GAS f32x4*)(m + D + 512 * j), sc1 = *(const GAS f32x4*)(m + D + 512 * j + 4);
                const f32x4 h0 = va * r * (sc0 + 1.0f) + sh0, h1 = vb * r * (sc1 + 1.0f) + sh1;
                u32x4 wh; wh.x = pk2(h0.x, h0.y); wh.y = pk2(h0.z, h0.w); wh.z = pk2(h1.x, h1.y); wh.w = pk2(h1.z, h1.w); o8[64 * j] = wh; }
        }
    }
#undef CMB_LOAD
#undef CMB_Y
}
#ifndef REPMASK
#define REPMASK 0
#endif
constexpr int NPH = 23;
#define PH_L(l, k) (2 + 10 * (l) + (k))

__global__ void __launch_bounds__(NTHR, 2) mk_fwd(Args args) {
    extern __shared__ __attribute__((aligned(16))) unsigned char lds_raw[];
    Frame F;
    F.lds = (LAS unsigned char*)lds_raw;
    F.MISC = (volatile LAS unsigned*)(F.lds + MISC_OFF);
    F.tid = threadIdx.x; F.lane = F.tid & 63; F.wave = __builtin_amdgcn_readfirstlane(F.tid >> 6);
    F.G = gridDim.x; { const int bx = blockIdx.x; F.vcu = (F.G % 8 == 0) ? (bx % 8) * (F.G / 8) + bx / 8 : bx; }
    F.ws = args.ws; F.ctl = (gu32*)(args.ws + WS_CTL);
    for (int u = F.tid; u < (LDS_BYTES - RING_BYTES) / 4; u += NTHR) ((LAS unsigned*)(F.lds + RING_BYTES))[u] = 0u;
    __syncthreads();
    (void)xcd_barrier_post((unsigned*)(F.ctl + CW_BAR), F.MISC + 8);
    const int lo = args.ph_lo, hi = args.ph_hi;
#define IN(k) (lo <= (k) && (k) < hi)
    const int vcu0 = F.vcu, wave0 = F.wave;
#define PH_ENTER() do { F.lane = lane_id_asm(); F.wave = opqs(wave0); F.tid = F.wave * 64 + F.lane; F.ws = opq(args.ws); F.ctl = (gu32*)F.ws; F.vcu = opqs(vcu0); } while (0)
#define SEAM(k) do { if (IN(k) && IN((k) + 1)) { XcdBarrier b2_; b2_.bar = (unsigned*)((gu32*)opq(args.ws) + CW_BAR); b2_.x = xb_xcc_id(); b2_.st = (volatile LAS unsigned*)(F.lds + MISC_OFF) + 8; xcd_barrier(b2_); } } while (0)

    if (IN(0)) { PH_ENTER(); p0_prologue(F, args); } SEAM(0);
    if (IN(1)) for (int rep_ = 0; rep_ < 1 + ((REPMASK >> 10) & 1); ++rep_) { PH_ENTER(); p1_prologue(F, args); } SEAM(1);
    for (int l = 0; l < DEPTH; ++l) {
        if (IN(PH_L(l, 0))) {
            PH_ENTER();
            const float* mod_l = (const float*)(F.ctl + CW_MOD) + (size_t)l * NB * 6 * D;
            if (l == 0) { norm_rows(F, opq(args.x), mod_l, 0, (bf16_t*)(F.ws + WS_HB)); if ((REPMASK >> 11) & 1) { for (int q_ = 0; q_ < 4; ++q_) norm_rows(F, opq(args.x), mod_l, 0, (bf16_t*)(F.ws + WS_HB)); } }
            else { convert_weights(F, args, l, 3); combine_phase<false>(F, opq(args.out), mod_l - (size_t)NB * 6 * D + 5 * D, mod_l); }
        } SEAM(PH_L(l, 0));
        if (IN(PH_L(l, 1))) for (int rep_ = 0; rep_ < 1 + ((REPMASK >> 1) & 1); ++rep_) {
            if ((REPMASK >> 3) & 1) { PH_ENTER(); hgrn_scan_phase(F); __syncthreads(); }
            PH_ENTER(); unsigned char* ws = F.ws;
#if defined(G1_STAG) && G1_STAG
            { const int cls_ = ((int)(blockIdx.x >> 3) & 7) % 3; for (int i_ = 0; i_ < cls_ * G1_STAG; ++i_) __builtin_amdgcn_s_sleep(64); }
#endif
            DenseOrder So; So.init(ws + WS_HB, ws + WS_WIN, T, INC - 512, D, F.G, opqs((int)blockIdx.x));
            EpiProj E{(bf16_t*)(ws + WS_QA), (bf16_t*)(ws + WS_KA), (bf16_t*)(ws + WS_VA), (bf16_t*)(ws + WS_QH), (bf16_t*)(ws + WS_IH), (bf16_t*)(ws + WS_OG), (float*)(ws + WS_GH),
                      (const float*)(ws + WS_ROPE_C), (const float*)(ws + WS_ROPE_S), opq(args.lb_params), l, wt_make(ws)};
            gemm_phase<EpiProj, DenseOrder, false>(F.lds + RING_OFF, D, So, E, F.tid);
        } SEAM(PH_L(l, 1));
        if (IN(PH_L(l, 2))) for (int rep_ = 0; rep_ < 1 + ((REPMASK >> 2) & 1); ++rep_) { PH_ENTER(); hgrn_local_phase(F); } SEAM(PH_L(l, 2));
        if (IN(PH_L(l, 3))) {
            PH_ENTER(); hgrn_scan_phase(F);
            { PH_ENTER(); unsigned char* ws = F.ws;
              DenseOrder So; So.init(ws + WS_HB, ws + WS_WIN, T, 512, D, F.G / 2, opqs((int)blockIdx.x), 12);
              if ((int)blockIdx.x >= F.G / 2) So.nwg = 0;
#if defined(OG_U8) && OG_U8
              EpiGateH E{(unsigned char*)(ws + WS_OG), wt_make(ws)};
              gemm_phase<EpiGateH, DenseOrder, false>(F.lds + RING_OFF, D, So, E, F.tid); }
#else
              EpiProj E{(bf16_t*)(ws + WS_QA), (bf16_t*)(ws + WS_KA), (bf16_t*)(ws + WS_VA), (bf16_t*)(ws + WS_QH), (bf16_t*)(ws + WS_IH), (bf16_t*)(ws + WS_OG), (float*)(ws + WS_GH),
                        (const float*)(ws + WS_ROPE_C), (const float*)(ws + WS_ROPE_S), opq(args.lb_params), l, wt_make(ws)};
              gemm_phase<EpiProj, DenseOrder, false>(F.lds + RING_OFF, D, So, E, F.tid); }
#endif
        } SEAM(PH_L(l, 3));
        if (IN(PH_L(l, 4))) for (int rep_ = 0; rep_ < 1 + ((REPMASK >> 4) & 1); ++rep_) { PH_ENTER(); if (!((REPMASK >> 12) & 1) || rep_ == 0) hgrn_out_phase(F); __syncthreads(); if (!((REPMASK >> 13) & 1) || rep_ == 0) attn_phase(F); } SEAM(PH_L(l, 4));
        if (IN(PH_L(l, 5))) for (int rep_ = 0; rep_ < 1 + ((REPMASK >> 5) & 1); ++rep_) { PH_ENTER(); merge_phase(F, opq(args.attn_norm) + l * AW, opq(args.hgrn_norm) + l * HW); } SEAM(PH_L(l, 5));
        if (IN(PH_L(l, 6))) for (int rep_ = 0; rep_ < 1 + (((REPMASK >> 6) & 1) && l == 0 ? 1 : 0); ++rep_) {
            PH_ENTER(); unsigned char* ws = F.ws;
            DenseOrder So; So.init(ws + WS_HB, ws + WS_WOUT, T, D, D, F.G, opqs((int)blockIdx.x));
#if defined(EPI_HOIST) && (EPI_HOIST & 1)
            if (l == 0) { EpiOut<true> E{opq(args.x), (const bf16_t*)(ws + WS_XB), (bf16_t*)(ws + WS_XB), (const float*)(F.ctl + CW_MOD) + (size_t)l * NB * 6 * D + 2 * D, true, wt_make(ws)};
                gemm_phase<EpiOut<true>, DenseOrder, false>(F.lds + RING_OFF, D, So, E, F.tid); }
            else { EpiOut<false> E{opq(args.x), (const bf16_t*)(ws + WS_XB), (bf16_t*)(ws + WS_XB), (const float*)(F.ctl + CW_MOD) + (size_t)l * NB * 6 * D + 2 * D, false, wt_make(ws)};
                gemm_phase<EpiOut<false>, DenseOrder, false>(F.lds + RING_OFF, D, So, E, F.tid); }
#else
            EpiOut E{opq(args.x), (const bf16_t*)(ws + WS_XB), (bf16_t*)(ws + WS_XB), (const float*)(F.ctl + CW_MOD) + (size_t)l * NB * 6 * D + 2 * D, l == 0, wt_make(ws)};
            gemm_phase<EpiOut, DenseOrder, false>(F.lds + RING_OFF, D, So, E, F.tid);
#endif
        } SEAM(PH_L(l, 6));
        if (IN(PH_L(l, 7))) for (int rep_ = 0; rep_ < 1 + ((REPMASK >> 7) & 1); ++rep_) { PH_ENTER(); router_phase(F, (const bf16_t*)(F.ws + WS_XB), (const float*)(F.ctl + CW_MOD) + (size_t)l * NB * 6 * D, opq(args.w_router), opq(args.b_router), l, rep_ == 1); } SEAM(PH_L(l, 7));
        if (IN(PH_L(l, 8))) { PH_ENTER(); scatter_phase(F, l); } SEAM(PH_L(l, 8));
        if (IN(PH_L(l, 9))) {
            { PH_ENTER(); unsigned char* ws = F.ws;
              MoeOrder<0> So{(const char*)(ws + WS_HB), (const char*)(ws + WS_WGU), (const unsigned*)(F.ctl + CW_CNT + l * 1024), (const int*)(ws + WS_LIST), D, F.G, opqs((int)blockIdx.x), (size_t)1024 * D * 2,
                          (unsigned*)(F.ctl + CW_RDY + l * 16384), (unsigned*)(F.ctl + CW_TMO)};
              So.load_counts();
              EpiGateUp E{(bf16_t*)(ws + WS_MH), (unsigned*)(F.ctl + CW_RDY + l * 16384), wt_make(ws)};
              gemm_phase<EpiGateUp, MoeOrder<0>, true>(F.lds + RING_OFF, D, So, E, F.tid); }
            { PH_ENTER(); unsigned char* ws = F.ws;
              MoeOrder<1> So{(const char*)(ws + WS_MH), (const char*)(ws + WS_WD), (const unsigned*)(F.ctl + CW_CNT + l * 1024), (const int*)(ws + WS_LIST), FF, F.G, opqs((int)blockIdx.x), (size_t)D * FF * 2,
                          (unsigned*)(F.ctl + CW_RDY + l * 16384), (unsigned*)(F.ctl + CW_TMO)};
              So.load_counts();
              EpiDown E{(bf16_t*)(ws + WS_Y), (const int*)(ws + WS_LIST), (const float*)(ws + WS_PW), wt_make(ws)};
              gemm_phase<EpiDown, MoeOrder<1>, false>(F.lds + RING_OFF, FF, So, E, F.tid); }
        } SEAM(PH_L(l, 9));
    }
    if (IN(NPH - 1)) { PH_ENTER(); combine_phase<true>(F, opq(args.out), (const float*)(F.ctl + CW_MOD) + (size_t)(DEPTH - 1) * NB * 6 * D + 5 * D, opq(args.final_norm)); }
#undef IN
#undef SEAM
#undef PH_ENTER
}
}
#ifndef MK_ONE_LAUNCH
#define MK_ONE_LAUNCH 0
#endif
extern "C" void kernel_launch(void* const* d_in, const int* in_sizes, int n_in, void* d_out, int out_size, void* d_ws, size_t ws_size, hipStream_t stream) {
    static int grid = 0;
    if (grid == 0) {
        int dev = 0, cus = 0; (void)hipGetDevice(&dev); (void)hipDeviceGetAttribute(&cus, hipDeviceAttributeMultiprocessorCount, dev);
        if (n_in != 16 || out_size != mk::T * mk::D || ws_size < mk::WS_END) { fprintf(stderr, "kernel_launch: unexpected problem (n_in %d, out %d, ws %zu)\n", n_in, out_size, ws_size); grid = -1; return; }
        if (hipFuncSetAttribute((const void*)mk::mk_fwd, hipFuncAttributeMaxDynamicSharedMemorySize, mk::LDS_BYTES) != hipSuccess) { fprintf(stderr, "hipFuncSetAttribute failed\n"); grid = -1; return; }
        grid = cus > 0 ? cus : 256;
    }
    if (grid < 0) return;
    mk::Args a{};
    a.x = (const float*)d_in[0]; a.c = (const float*)d_in[1]; a.positions = (const int*)d_in[2]; a.w_in = (const float*)d_in[3]; a.w_out = (const float*)d_in[4]; a.attn_norm = (const float*)d_in[5];
    a.hgrn_norm = (const float*)d_in[6]; a.lb_params = (const float*)d_in[7]; a.ada_w = (const float*)d_in[8]; a.ada_b = (const float*)d_in[9]; a.w_router = (const float*)d_in[10]; a.b_router = (const float*)d_in[11];
    a.w_gate = (const float*)d_in[12]; a.w_up = (const float*)d_in[13]; a.w_down = (const float*)d_in[14]; a.final_norm = (const float*)d_in[15]; a.out = (float*)d_out; a.ws = (unsigned char*)d_ws;
    (void)hipMemsetAsync((char*)d_ws + mk::WS_CTL, 0, mk::CTL_BYTES, stream);
#if MK_ONE_LAUNCH
    a.ph_lo = 0; a.ph_hi = mk::NPH;
    hipLaunchKernelGGL(mk::mk_fwd, dim3(grid), dim3(mk::NTHR), mk::LDS_BYTES, stream, a);
#else
    for (int p = 0; p < mk::NPH; ++p) { a.ph_lo = p; a.ph_hi = p + 1; hipLaunchKernelGGL(mk::mk_fwd, dim3(grid), dim3(mk::NTHR), mk::LDS_BYTES, stream, a); }
#endif
}
```

```cpp
#define MK_ONE_LAUNCH 1
#define WT_STORES 0
#define NT_ONCE 1
#define CNT_CACHE 1
#define EARLY_ACQ 1
#define HG_WIDE 1
#define PRO_POLISH 1
#define Y_FP8 1
#define BR_FP8 3
#define OUT16 1
#define SLACK_CONV 1
#define RT_ATOMIC 1
#define ATT_ROT 1
#define ROPE_BF 1
#define RT_ILP 1
#define RT_DEFER 1
#define HW_PK2 1
#define P0_CONV 1
#include <hip/hip_runtime.h>
#include <cstdio>
#include <cstdint>
namespace mk {
#define LAS __attribute__((address_space(3)))
#define GAS __attribute__((address_space(1)))
typedef unsigned short bf16_t;
typedef short bf16x8 __attribute__((ext_vector_type(8)));
typedef short s16x4 __attribute__((ext_vector_type(4)));
typedef float f32x2 __attribute__((ext_vector_type(2)));
typedef float f32x4 __attribute__((ext_vector_type(4)));
typedef float f32x16 __attribute__((ext_vector_type(16)));
typedef unsigned u32x2 __attribute__((ext_vector_type(2)));
typedef unsigned u32x4 __attribute__((ext_vector_type(4)));
typedef unsigned gu32;

constexpr int D = 1024, NB = 2, S = 8192, T = NB * S, DEPTH = 2, AW = 512, HW = 512, HD = 64, NH = 8, INC = 3584, NE = 16, FF = 512;
constexpr float EPS = 1e-6f;
constexpr float LOG2E = 1.4426950408889634f;
constexpr float QSCALE = 0.125f * LOG2E;
constexpr int NWAVES = 8, NTHR = 512;

constexpr size_t MiB = 1u << 20;
#if defined(PRO_POLISH) && PRO_POLISH
constexpr size_t WS_CTL = 0, CTL_BYTES = 192 * 1024;
#else
constexpr size_t WS_CTL = 0, CTL_BYTES = 1 * MiB;
#endif
constexpr size_t WS_ROPE_C = 1 * MiB, WS_ROPE_S = 3 * MiB;
constexpr size_t WS_LIST = 5 * MiB, WS_PW = 6 * MiB;
constexpr size_t WS_CNTB = 8 * MiB + 512 * 1024, WS_SELG = 8 * MiB + 576 * 1024;
constexpr size_t WS_LSE = 7 * MiB;
constexpr size_t WS_DEC = 9 * MiB;
constexpr size_t WS_WIN = 10 * MiB, WS_WOUT = 17 * MiB, WS_WGU = 19 * MiB, WS_WD = 51 * MiB;
constexpr size_t WS_HB = 68 * MiB;
constexpr size_t WS_QA = 100 * MiB, WS_KA = 116 * MiB, WS_VA = 132 * MiB, WS_QH = 148 * MiB, WS_IH = 164 * MiB, WS_OG = 180 * MiB;
constexpr size_t WS_GH = 196 * MiB;
constexpr size_t WS_ADAP = 228 * MiB;
constexpr size_t WS_PART = 228 * MiB;
constexpr size_t WS_REC = 276 * MiB;
constexpr size_t WS_SLOC = 292 * MiB;
constexpr size_t WS_XB = 308 * MiB;
constexpr size_t WS_MH = 100 * MiB;
constexpr size_t WS_Y = 134 * MiB;
constexpr size_t WS_END = 340 * MiB;
static_assert(WS_MH + (size_t)(2 * T + 256) * FF * 2 <= WS_Y && WS_Y + (size_t)2 * T * D * 2 <= WS_PART, "ws overlay map");

constexpr int CW_BAR = 1024;
constexpr int CW_CNT = 8192;
#if defined(PRO_POLISH) && PRO_POLISH
constexpr int CW_RDY = 16384, CW_TMO = 12288, CW_MOD = 49152;
#else
constexpr int CW_RDY = 65536;
constexpr int CW_TMO = 200000;
constexpr int CW_MOD = 16384;
#endif
constexpr int CW_ADAP = 65536;

__device__ __forceinline__ int lane_id_asm2() { int l; asm volatile("v_mbcnt_lo_u32_b32 %0, -1, 0\n\tv_mbcnt_hi_u32_b32 %0, -1, %0" : "=v"(l)); return l; }
__device__ __forceinline__ float wave_sum(float v) {
    v += __builtin_bit_cast(float, __builtin_amdgcn_update_dpp(0, __builtin_bit_cast(int, v), 0xB1, 0xF, 0xF, false));
    v += __builtin_bit_cast(float, __builtin_amdgcn_update_dpp(0, __builtin_bit_cast(int, v), 0x4E, 0xF, 0xF, false));
    v += __builtin_bit_cast(float, __builtin_amdgcn_update_dpp(0, __builtin_bit_cast(int, v), 0x141, 0xF, 0xF, false));
    v += __builtin_bit_cast(float, __builtin_amdgcn_update_dpp(0, __builtin_bit_cast(int, v), 0x140, 0xF, 0xF, false));
    v += __builtin_bit_cast(float, __builtin_amdgcn_update_dpp(0, __builtin_bit_cast(int, v), 0x142, 0xA, 0xF, false));
    v += __builtin_bit_cast(float, __builtin_amdgcn_update_dpp(0, __builtin_bit_cast(int, v), 0x143, 0xC, 0xF, false));
    return __builtin_bit_cast(float, __builtin_amdgcn_readlane(__builtin_bit_cast(int, v), 63));
}
__device__ __forceinline__ float xhalf_max(float x) { const int l = lane_id_asm2(); return fmaxf(x, __builtin_bit_cast(float, __builtin_amdgcn_ds_bpermute((l ^ 32) << 2, __builtin_bit_cast(int, x)))); }
__device__ __forceinline__ float xhalf_sum(float x) { const int l = lane_id_asm2(); return x + __builtin_bit_cast(float, __builtin_amdgcn_ds_bpermute((l ^ 32) << 2, __builtin_bit_cast(int, x))); }
__device__ __forceinline__ unsigned f2bf(float f) { unsigned u = __builtin_bit_cast(unsigned, f); return (u + 0x7fffu + ((u >> 16) & 1u)) >> 16; }
typedef __bf16 bf16x2_t __attribute__((ext_vector_type(2)));
#if defined(HW_PK2) && HW_PK2
__device__ __forceinline__ unsigned pk2(float lo, float hi) { f32x2 v = {lo, hi}; bf16x2_t b = __builtin_convertvector(v, bf16x2_t); return __builtin_bit_cast(unsigned, b); }
#else
__device__ __forceinline__ unsigned pk2(float lo, float hi) { return f2bf(lo) | (f2bf(hi) << 16); }
#endif
__device__ __forceinline__ float bf2f(unsigned short b) { return __builtin_bit_cast(float, ((unsigned)b) << 16); }
__device__ __forceinline__ float bflo(unsigned w) { return __builtin_bit_cast(float, w << 16); }
__device__ __forceinline__ float bfhi(unsigned w) { return __builtin_bit_cast(float, w & 0xffff0000u); }
__device__ __forceinline__ float silu_f(float x) { return x * __builtin_amdgcn_rcpf(1.f + __expf(-x)); }
__device__ __forceinline__ float sigm_f(float x) { return __builtin_amdgcn_rcpf(1.f + __expf(-x)); }
template <class Tp> __device__ __forceinline__ Tp* opq(Tp* p) { asm volatile("" : "+s"(p)); return p; }
__device__ __forceinline__ int opqv(int v) { asm volatile("" : "+v"(v)); return v; }
__device__ __forceinline__ int opqs(int v) { asm volatile("" : "+s"(v)); return v; }
__device__ __forceinline__ int lane_id_asm() { int l; asm volatile("v_mbcnt_lo_u32_b32 %0, -1, 0\n\tv_mbcnt_hi_u32_b32 %0, -1, %0" : "=v"(l)); return l; }
#if defined(NT_ONCE) && NT_ONCE
#define NT_LOAD(p) __builtin_nontemporal_load(p)
#else
#define NT_LOAD(p) (*(p))
#endif
#define F8SAT(x) __builtin_amdgcn_fmed3f((x), -448.0f, 448.0f)
#define LDS_WAIT() asm volatile("s_waitcnt lgkmcnt(0)" ::: "memory")
#define VM_WAIT() asm volatile("s_waitcnt vmcnt(0)" ::: "memory")

#define XB_TMO      128
#define XB_XCNT(j)  (256  + 64 * (j))
#define XB_XSUB(j)  (1280 + 64 * (j))
#define XB_XGEN(j)  (2304 + 64 * (j))
#define XB_TOP      3328
#define XB_TOPGEN   3392
#define XCD_BAR_WORDS 3456
#define XB_SPIN_CAP (1u << 18)
__device__ __forceinline__ unsigned xb_ld(unsigned* p)              { return __hip_atomic_load(p, __ATOMIC_RELAXED, __HIP_MEMORY_SCOPE_AGENT); }
__device__ __forceinline__ unsigned xb_add(unsigned* p, unsigned v) { return __hip_atomic_fetch_add(p, v, __ATOMIC_RELAXED, __HIP_MEMORY_SCOPE_AGENT); }
__device__ __forceinline__ unsigned xb_xcc_id() { return (unsigned)__builtin_amdgcn_s_getreg((3 << 11) | 20) & 0xFu; }
#define XB_SPIN(cond, bar) do { unsigned _sp = 0; while (cond) { __builtin_amdgcn_s_sleep(1); \
    if ((++_sp & 255u) == 0u) { if (xb_ld(&(bar)[XB_TMO])) break; if (_sp > XB_SPIN_CAP) { atomicAdd(&(bar)[XB_TMO], 1u); break; } } } } while (0)
struct XcdBarrier { unsigned* bar; unsigned x; volatile LAS unsigned* st; };
__device__ __forceinline__ XcdBarrier xcd_barrier_post(unsigned* bar, volatile LAS unsigned* st) {
    XcdBarrier b; b.bar = bar; b.x = xb_xcc_id(); b.st = st;
    if (threadIdx.x == 0) (void)xb_add(&bar[XB_XCNT(b.x)], 1u);
    return b;
}
__device__ __forceinline__ void xcd_barrier_complete(unsigned* bar, unsigned x, unsigned& nloc, unsigned& nx) {
    const unsigned G = gridDim.x * gridDim.y * gridDim.z;
    unsigned sum, cnt, mine, sp = 0u;
    for (;;) {
        sum = 0u; cnt = 0u; mine = 0u;
#pragma unroll
        for (unsigned j = 0; j < 16; ++j) { const unsigned c = xb_ld(&bar[XB_XCNT(j)]); sum += c; cnt += (c > 0u) ? 1u : 0u; mine = (j == x) ? c : mine; }
        if (sum == G) break;
        __builtin_amdgcn_s_sleep(1);
        if ((++sp & 255u) == 0u) { if (xb_ld(&bar[XB_TMO])) break; if (sp > XB_SPIN_CAP) { atomicAdd(&bar[XB_TMO], 1u); break; } }
    }
    nloc = mine > 0u ? mine : 1u; nx = cnt > 0u ? cnt : 1u;
}
__device__ __forceinline__ void xcd_barrier(const XcdBarrier& b) {
    asm volatile("s_waitcnt vmcnt(0)" ::: "memory");
    __syncthreads();
    if (threadIdx.x == 0) {
        unsigned* bar = b.bar;
        __builtin_amdgcn_s_waitcnt(0);
        unsigned nloc = b.st[0], nx = b.st[1];
        if (nloc == 0u) { xcd_barrier_complete(bar, b.x, nloc, nx); b.st[0] = nloc; b.st[1] = nx; }
        const unsigned old = xb_add(&bar[XB_XSUB(b.x)], 1u);
        const unsigned gen = old / nloc;
        if (old + 1u == (gen + 1u) * nloc) {
            __builtin_amdgcn_fence(__ATOMIC_RELEASE, "agent");
            asm volatile("s_waitcnt vmcnt(0)" ::: "memory");
            const unsigned og = xb_add(&bar[XB_TOP], 1u);
            const unsigned tg = og / nx;
            if (og + 1u == (tg + 1u) * nx) xb_add(&bar[XB_TOPGEN], 1u);
            else XB_SPIN(xb_ld(&bar[XB_TOPGEN]) == tg, bar);
            __builtin_amdgcn_fence(__ATOMIC_ACQUIRE, "agent");
            xb_add(&bar[XB_XGEN(b.x)], 1u);
            asm volatile("s_waitcnt vmcnt(0)" ::: "memory");
        } else {
            XB_SPIN(xb_ld(&bar[XB_XGEN(b.x)]) == gen, bar);
            __builtin_amdgcn_fence(__ATOMIC_ACQUIRE, "agent");
            asm volatile("s_waitcnt vmcnt(0)" ::: "memory");
        }
    }
    __syncthreads();
}

constexpr int BM = 256, BK = 64, HALF = 128, HTB = HALF * BK * 2, STAGE_BYTES = 8 * HTB;
__host__ __device__ __forceinline__ int lds_byte(int r, int c) { const int st = (r >> 4) * 2 + (c >> 5), rr = r & 15, cc = c & 31, ob = rr * 64 + cc * 2; return st * 1024 + (ob ^ (((ob >> 9) & 1) << 5)); }
__host__ __device__ __forceinline__ void stage_rc(int b, int& R, int& C) { const int st = b / 1024, sb = b % 1024, swz = sb ^ (((sb >> 9) & 1) << 5); R = (st >> 1) * 16 + swz / 64; C = (st & 1) * 32 + (swz % 64) / 2; }
__host__ __device__ __forceinline__ int perm32(int rho) { const int n = rho >> 4, i = rho & 15; return 8 * (i >> 2) + 4 * n + (i & 3); }
__device__ __forceinline__ unsigned cvt_pk_bf16(float lo, float hi) { f32x2 v = {lo, hi}; bf16x2_t b = __builtin_convertvector(v, bf16x2_t); return __builtin_bit_cast(unsigned, b); }
__device__ __forceinline__ unsigned cvt1_bf16(float x) { return cvt_pk_bf16(x, 0.f) & 0xffffu; }

struct GUnit { const char* A; const char* B; int pm, pn; int e, row0, nrows, rtg; };

template <class Epi, class Sched, bool GATHER>
__device__ __forceinline__ void gemm_phase(LAS unsigned char* lds, const int K, const Sched& S, const Epi& E, const int tid) {
    const int wid = __builtin_amdgcn_readfirstlane(tid >> 6), lane = tid & 63, wr = wid >> 2, wc = wid & 3, fr = lane & 15, fq = lane >> 4;
    const int nt = K / BK;
    unsigned voffB[2];
#pragma unroll
    for (int i = 0; i < 2; ++i) { int R_, C_; stage_rc(tid * 16 + i * 8192, R_, C_);
        const int Rb = Epi::PERM16 ? (64 * (R_ >> 5) + 16 * ((R_ & 15) >> 2) + 4 * ((R_ & 31) >> 4) + (R_ & 3)) : Epi::PERM ? ((R_ & ~31) + perm32(R_ & 31)) : R_;
        voffB[i] = (unsigned)(Rb * K + C_) * 2u; }
#define PG8_VOA(dst, unit) do { _Pragma("unroll") for (int h_ = 0; h_ < 2; ++h_) _Pragma("unroll") for (int i_ = 0; i_ < 2; ++i_) { int R_, C_; stage_rc(tid * 16 + i_ * 8192, R_, C_); \
        dst[h_][i_] = GATHER ? (unsigned)S.arow(unit, h_ * HALF + R_) * (unsigned)(K * 2) + (unsigned)C_ * 2u : (unsigned)((h_ * HALF + R_) * K + C_) * 2u; } } while (0)
    const size_t kstep = (size_t)(BK * 2);
    const size_t hstep = Epi::PERM16 ? (size_t)8 * K * 2 : (size_t)HALF * K * 2;
    const unsigned ldsw = (unsigned)wid * 1024u;
    const int aoff = lds_byte(wr * 64 + fr, fq * 8), boff = lds_byte(wc * 32 + fr, fq * 8);
#define PG8_SA(b, h) (((b) * 2 + (h)) * HTB)
#define PG8_SB(b, h) ((4 + (b) * 2 + (h)) * HTB)
#define PG8_STAGE(bufoff, gbase, voff) do { _Pragma("unroll") for (int _i = 0; _i < 2; ++_i) \
        __builtin_amdgcn_global_load_lds((const unsigned*)((const char*)(gbase) + (voff)[_i]), (LAS unsigned*)(lds + (bufoff) + ldsw + _i * 8192), 16, 0, 0); } while (0)
#define PG8_LDA(dst, b, h) do { _Pragma("unroll") for (int m = 0; m < 4; ++m) _Pragma("unroll") for (int k = 0; k < 2; ++k) dst[m][k] = *(const LAS bf16x8*)(lds + PG8_SA(b, h) + aoff + m * 2048 + k * 1024); } while (0)
#define PG8_LDB(dst, b, h) do { _Pragma("unroll") for (int n = 0; n < 2; ++n) _Pragma("unroll") for (int k = 0; k < 2; ++k) dst[n][k] = *(const LAS bf16x8*)(lds + PG8_SB(b, h) + boff + n * 2048 + k * 1024); } while (0)
#define PG8_MMA(ai, bj, At, Bt) do { __builtin_amdgcn_s_setprio(1); _Pragma("unroll") for (int m = 0; m < 4; ++m) _Pragma("unroll") for (int n = 0; n < 2; ++n) _Pragma("unroll") for (int k = 0; k < 2; ++k) \
        acc[ai][bj][m][n] = __builtin_amdgcn_mfma_f32_16x16x32_bf16(Bt[n][k], At[m][k], acc[ai][bj][m][n], 0, 0, 0); __builtin_amdgcn_s_setprio(0); } while (0)
#define PG8_WAIT_V(n) asm volatile("s_waitcnt vmcnt(" #n ")" ::: "memory")
#define PG8_WAIT_L(n) asm volatile("s_waitcnt lgkmcnt(" #n ")" ::: "memory")
#define PG8_BAR __builtin_amdgcn_s_barrier()
#define PG8_SCHED __builtin_amdgcn_sched_barrier(0)
    GUnit cur, nxt; int ui = 0;
    if (!S.next(0, cur)) return;
    typename Sched::Early est; S.early_reset(est);
    unsigned voA[2][2], voN[2][2];
    PG8_VOA(voA, cur);
    float z0 = 0.f; asm volatile("" : "+v"(z0));
    f32x4 acc[2][2][4][2];
#pragma unroll
    for (int a = 0; a < 2; ++a)
#pragma unroll
        for (int b = 0; b < 2; ++b)
#pragma unroll
            for (int m = 0; m < 4; ++m)
#pragma unroll
                for (int n = 0; n < 2; ++n) acc[a][b][m][n] = (f32x4){z0, z0, z0, z0};
    bf16x8 At[4][2], B0[2][2], B1[2][2];
    const char* cA = cur.A; const char* cB = cur.B;
    S.a_ready(cur, 0, est);
    PG8_STAGE(PG8_SB(0, 0), cB, voffB); PG8_STAGE(PG8_SB(0, 1), cB + hstep, voffB); PG8_STAGE(PG8_SA(0, 0), cA, voA[0]); PG8_STAGE(PG8_SA(0, 1), cA, voA[1]);
    if (wr == 1) PG8_BAR;
    PG8_WAIT_V(2); PG8_BAR;
    PG8_STAGE(PG8_SB(1, 0), cB + kstep, voffB); PG8_STAGE(PG8_SA(1, 0), cA + kstep, voA[0]); PG8_STAGE(PG8_SB(1, 1), cB + hstep + kstep, voffB);
    PG8_WAIT_V(6); PG8_BAR;
    for (;;) {
        const bool has_next = S.next(ui + 1, nxt);
        const char* nA = has_next ? nxt.A : cA; const char* nB = has_next ? nxt.B : cB;
        for (int t = 0; t < nt; t += 2) {
            const bool last = (t == nt - 2);
            if (last && has_next) S.a_ready(nxt, ui + 1, est);
            if (Sched::mode == 1 && !last && has_next) S.a_early(nxt, est);
            if (GATHER && last) {
                if (has_next) PG8_VOA(voN, nxt);
                else {
#pragma unroll
                    for (int h = 0; h < 2; ++h)
#pragma unroll
                        for (int i = 0; i < 2; ++i) voN[h][i] = voA[h][i];
                }
            }
            const char* a1 = cA + (size_t)(t + 1) * kstep;
            const char* a2 = last ? nA : cA + (size_t)(t + 2) * kstep; const char* b2 = last ? nB : cB + (size_t)(t + 2) * kstep;
            const char* a3 = a2 + kstep; const char* b3 = b2 + kstep;
            unsigned v2[2][2];
#pragma unroll
            for (int h = 0; h < 2; ++h)
#pragma unroll
                for (int i = 0; i < 2; ++i) v2[h][i] = (GATHER && last) ? voN[h][i] : voA[h][i];
            PG8_LDB(B0, 0, 0); PG8_LDB(B1, 0, 1); PG8_SCHED; PG8_LDA(At, 0, 0); PG8_STAGE(PG8_SA(1, 1), a1, voA[1]);
            PG8_WAIT_V(8); PG8_WAIT_L(0); PG8_BAR; PG8_MMA(0, 0, At, B0); PG8_MMA(0, 1, At, B1); PG8_BAR; PG8_SCHED;
            PG8_LDA(At, 0, 1); PG8_STAGE(PG8_SB(0, 0), b2, voffB); PG8_STAGE(PG8_SB(0, 1), b2 + hstep, voffB); PG8_STAGE(PG8_SA(0, 0), a2, v2[0]);
            PG8_WAIT_V(8); PG8_WAIT_L(0); PG8_BAR; PG8_MMA(1, 0, At, B0); PG8_MMA(1, 1, At, B1); PG8_BAR; PG8_SCHED;
            PG8_LDB(B0, 1, 0); PG8_LDB(B1, 1, 1); PG8_SCHED; PG8_LDA(At, 1, 0); PG8_STAGE(PG8_SA(0, 1), a2, v2[1]);
            PG8_WAIT_V(8); PG8_WAIT_L(0); PG8_BAR; PG8_MMA(0, 0, At, B0); PG8_MMA(0, 1, At, B1); PG8_BAR; PG8_SCHED;
            PG8_LDA(At, 1, 1); PG8_STAGE(PG8_SB(1, 0), b3, voffB); PG8_STAGE(PG8_SB(1, 1), b3 + hstep, voffB); PG8_STAGE(PG8_SA(1, 0), a3, v2[0]);
            PG8_WAIT_V(8); PG8_WAIT_L(0); PG8_BAR; PG8_MMA(1, 0, At, B0); PG8_MMA(1, 1, At, B1); PG8_BAR; PG8_SCHED;
        }
        if (wr == 0) PG8_BAR;
        E(acc, cur, wr, wc, fr, fq);
#if defined(PROBE_EPI2)
        if (Epi::PROBE2) E(acc, cur, wr, wc, fr, fq);
#endif
#if defined(PROBE_EPI3)
        if (Epi::PROBE2) {
#if PROBE_EPI3 == 2
            const int jb = 228 * 1048576 + (int)blockIdx.x * 131072 + (wr * 64 + fr) * 1024 + (wc * 32 + 8 * fq) * 2;
#define PEPI3_OFF(a, b, m) (((a) * 128 + (m) * 16) * 1024 + (b) * 256)
#else
            const int jb = 228 * 1048576 + ((int)(blockIdx.x * 8 + wid) * 16) * 1024 + (tid & 63) * 16;
#define PEPI3_OFF(a, b, m) ((((a) * 2 + (b)) * 4 + (m)) * 1024)
#endif
#pragma unroll
            for (int a = 0; a < 2; ++a)
#pragma unroll
                for (int b = 0; b < 2; ++b)
#pragma unroll
                    for (int m = 0; m < 4; ++m) { u32x4 x; x.x = cvt_pk_bf16(acc[a][b][m][0][0], acc[a][b][m][0][1]); x.y = cvt_pk_bf16(acc[a][b][m][0][2], acc[a][b][m][0][3]); x.z = cvt_pk_bf16(acc[a][b][m][1][0], acc[a][b][m][1][1]); x.w = cvt_pk_bf16(acc[a][b][m][1][2], acc[a][b][m][1][3]);
                        __builtin_amdgcn_raw_buffer_store_b128(x, E.wt.rs, jb, PEPI3_OFF(a, b, m), 0); }
        }
#endif
        if (!has_next) break;
#pragma unroll
        for (int a = 0; a < 2; ++a)
#pragma unroll
            for (int b = 0; b < 2; ++b)
#pragma unroll
                for (int m = 0; m < 4; ++m)
#pragma unroll
                    for (int n = 0; n < 2; ++n) acc[a][b][m][n] = (f32x4){z0, z0, z0, z0};
        cur = nxt; cA = nA; cB = nB; ++ui;
        if (GATHER) {
#pragma unroll
            for (int h = 0; h < 2; ++h)
#pragma unroll
                for (int i = 0; i < 2; ++i) voA[h][i] = voN[h][i];
        }
        if (wr == 1) PG8_BAR;
    }
    PG8_WAIT_V(0);
    PG8_BAR;
#undef PG8_VOA
#undef PG8_SA
#undef PG8_SB
#undef PG8_STAGE
#undef PG8_LDA
#undef PG8_LDB
#undef PG8_MMA
#undef PG8_WAIT_V
#undef PG8_WAIT_L
#undef PG8_BAR
#undef PG8_SCHED
}
struct DenseOrder {
    const char* A; const char* Bt; int K, nM, nN, nwg, G, c, pn0;
    __device__ __forceinline__ void init(const void* A_, const void* Bt_, int M, int N, int K_, int G_, int c_, int pn0_ = 0) { A = (const char*)A_; Bt = (const char*)Bt_; K = K_; nM = M / BM; nN = N / BM; nwg = nM * nN; G = G_; c = c_; pn0 = pn0_; }
    __device__ __forceinline__ bool next(int i, GUnit& u) const {
        const long L = (long)i * G + c; if (L >= nwg) return false;
        int wgid = (int)L; { const int q = nwg / 8, r = nwg % 8, xcd = wgid % 8, off = wgid / 8; wgid = (xcd < r ? xcd * (q + 1) : r * (q + 1) + (xcd - r) * q) + off; }
        const int nig = 8 * nN, gid = wgid / nig, fm = gid * 8, gsz = (nM - fm) < 8 ? (nM - fm) : 8;
        u.pm = fm + ((wgid % nig) % gsz); u.pn = pn0 + (wgid % nig) / gsz;
        u.A = A + (size_t)u.pm * BM * K * 2; u.B = Bt + (size_t)u.pn * BM * K * 2; u.e = 0; u.row0 = 0; u.nrows = BM; u.rtg = 0; return true;
    }
    __device__ __forceinline__ int arow(const GUnit&, int) const { return 0; }
    static constexpr int mode = 0;
    struct Early {};
    __device__ __forceinline__ void early_reset(Early&) const {}
    __device__ __forceinline__ void a_early(const GUnit&, Early&) const {}
    __device__ __forceinline__ void a_ready(const GUnit&, int, Early&) const {}
};

struct WtBuf { __amdgpu_buffer_rsrc_t rs; const unsigned char* base; };
__device__ __forceinline__ WtBuf wt_make(const unsigned char* base) { WtBuf w; w.rs = __builtin_amdgcn_make_buffer_rsrc((void*)base, 0, 0x7fffffff, 0x00020000); w.base = base; return w; }
__device__ __forceinline__ void wt_store16(const WtBuf& w, const void* p, u32x4 v) {
#if defined(WT_STORES) && WT_STORES
    __builtin_amdgcn_raw_buffer_store_b128(v, w.rs, (int)(unsigned)((const unsigned char*)p - w.base), 0, 16);
#else
    *(GAS u32x4*)p = v;
#endif
}
__device__ __forceinline__ void st8w(const WtBuf& w, bf16_t* p, f32x4 v0, f32x4 v1) {
    u32x4 x; x.x = cvt_pk_bf16(v0[0], v0[1]); x.y = cvt_pk_bf16(v0[2], v0[3]); x.z = cvt_pk_bf16(v1[0], v1[1]); x.w = cvt_pk_bf16(v1[2], v1[3]);
    wt_store16(w, p, x);
}
__device__ __forceinline__ u32x4 lane_tr(u32x4 x, int pa) {
    x.x = (unsigned)__builtin_amdgcn_ds_bpermute(pa, (int)x.x); x.y = (unsigned)__builtin_amdgcn_ds_bpermute(pa, (int)x.y); x.z = (unsigned)__builtin_amdgcn_ds_bpermute(pa, (int)x.z); x.w = (unsigned)__builtin_amdgcn_ds_bpermute(pa, (int)x.w); return x; }
__device__ __forceinline__ void st8p(const WtBuf& w, bf16_t* p, f32x4 v0, f32x4 v1, int pa) {
    u32x4 x; x.x = cvt_pk_bf16(v0[0], v0[1]); x.y = cvt_pk_bf16(v0[2], v0[3]); x.z = cvt_pk_bf16(v1[0], v1[1]); x.w = cvt_pk_bf16(v1[2], v1[3]);
#if defined(EPI_TR) && EPI_TR
    x = lane_tr(x, pa);
#endif
    wt_store16(w, p, x);
}
__device__ __forceinline__ void st8(bf16_t* p, f32x4 v0, f32x4 v1) {
    u32x4 w; w.x = cvt_pk_bf16(v0[0], v0[1]); w.y = cvt_pk_bf16(v0[2], v0[3]); w.z = cvt_pk_bf16(v1[0], v1[1]); w.w = cvt_pk_bf16(v1[2], v1[3]);
    *(GAS u32x4*)p = w;
}

struct EpiProj {
    static constexpr bool PROBE2 = true;
    static constexpr bool PERM = true;
    static constexpr bool PERM16 = false;
    bf16_t *QA, *KA, *VA, *QH, *IH, *OG; float* GH; const float* ct; const float* st; const float* lbp; int layer; WtBuf wt;
    __device__ __forceinline__ void operator()(const f32x4 (&acc)[2][2][4][2], const GUnit& u, int wr, int wc, int fr, int fq) const {
        const int kind = u.pn >> 1, sub = u.pn & 1;
        const int row0 = u.pm * BM + wr * 64 + fr;
#if defined(EPI_TR) && EPI_TR
        const int ln_ = fq * 16 + fr, frs = ln_ >> 2, fqs = ln_ & 3, pa = (16 * fqs + frs) << 2;
#else
        const int frs = fr, fqs = fq, pa = 0;
#endif
        const int rowS = u.pm * BM + wr * 64 + frs;
        if (kind <= 1) {
            bf16_t* dst = (kind == 0 ? QA : KA); const float sc = (kind == 0) ? QSCALE : 1.0f;
            const int head = 4 * sub + wc;
#if defined(EPI_HOIST) && (EPI_HOIST & 2)
            f32x4 o1[2][4][2], o2[2][4][2];
#pragma unroll
            for (int ai = 0; ai < 2; ++ai) {
                f32x4 cs[4][4];
#pragma unroll
                for (int m = 0; m < 4; ++m) { const size_t to = (size_t)(row0 + ai * HALF + m * 16) * 32 + 8 * fq;
                    cs[m][0] = *(const GAS f32x4*)(ct + to); cs[m][1] = *(const GAS f32x4*)(ct + to + 4); cs[m][2] = *(const GAS f32x4*)(st + to); cs[m][3] = *(const GAS f32x4*)(st + to + 4); }
#pragma unroll
                for (int m = 0; m < 4; ++m) {
                    const f32x4 a0 = acc[ai][0][m][0], a1 = acc[ai][0][m][1], b0 = acc[ai][1][m][0], b1 = acc[ai][1][m][1];
                    o1[ai][m][0] = (a0 * cs[m][0] - b0 * cs[m][2]) * sc; o1[ai][m][1] = (a1 * cs[m][1] - b1 * cs[m][3]) * sc;
                    o2[ai][m][0] = (a0 * cs[m][2] + b0 * cs[m][0]) * sc; o2[ai][m][1] = (a1 * cs[m][3] + b1 * cs[m][1]) * sc; }
                asm volatile("" ::: "memory"); __builtin_amdgcn_sched_barrier(0);
            }
#pragma unroll
            for (int ai = 0; ai < 2; ++ai)
#pragma unroll
                for (int m = 0; m < 4; ++m) { bf16_t* p = dst + (size_t)(rowS + ai * HALF + m * 16) * AW + head * HD + 8 * fqs;
                    st8p(wt, p, o1[ai][m][0], o1[ai][m][1], pa); st8p(wt, p + 32, o2[ai][m][0], o2[ai][m][1], pa); }
#elif defined(ROPE_BF) && ROPE_BF
            const GAS unsigned* rp = (const GAS unsigned*)ct;
            u32x4 tn0 = *(const GAS u32x4*)(rp + (size_t)row0 * 32 + 8 * fq), tn1 = *(const GAS u32x4*)(rp + (size_t)row0 * 32 + 8 * fq + 4);
#pragma unroll
            for (int g = 0; g < 8; ++g) { const int ai = g >> 2, m = g & 3, r = row0 + ai * HALF + m * 16;
                const u32x4 t0 = tn0, t1 = tn1;
                if (g < 7) { const int r2 = row0 + ((g + 1) >> 2) * HALF + ((g + 1) & 3) * 16;
                    tn0 = *(const GAS u32x4*)(rp + (size_t)r2 * 32 + 8 * fq); tn1 = *(const GAS u32x4*)(rp + (size_t)r2 * 32 + 8 * fq + 4); }
                const f32x4 c0 = {bflo(t0.x), bflo(t0.y), bflo(t0.z), bflo(t0.w)}, s0 = {bfhi(t0.x), bfhi(t0.y), bfhi(t0.z), bfhi(t0.w)};
                const f32x4 c1 = {bflo(t1.x), bflo(t1.y), bflo(t1.z), bflo(t1.w)}, s1 = {bfhi(t1.x), bfhi(t1.y), bfhi(t1.z), bfhi(t1.w)};
                const f32x4 a0 = acc[ai][0][m][0], a1 = acc[ai][0][m][1], b0 = acc[ai][1][m][0], b1 = acc[ai][1][m][1];
                const f32x4 o10 = (a0 * c0 - b0 * s0) * sc, o11 = (a1 * c1 - b1 * s1) * sc, o20 = (a0 * s0 + b0 * c0) * sc, o21 = (a1 * s1 + b1 * c1) * sc;
                bf16_t* p = dst + (size_t)(r - row0 + rowS) * AW + head * HD + 8 * fqs;
                st8p(wt, p, o10, o11, pa); st8p(wt, p + 32, o20, o21, pa); }
#else
            f32x4 cn0 = *(const GAS f32x4*)(ct + (size_t)row0 * 32 + 8 * fq), cn1 = *(const GAS f32x4*)(ct + (size_t)row0 * 32 + 8 * fq + 4);
            f32x4 sn0 = *(const GAS f32x4*)(st + (size_t)row0 * 32 + 8 * fq), sn1 = *(const GAS f32x4*)(st + (size_t)row0 * 32 + 8 * fq + 4);
#pragma unroll
            for (int g = 0; g < 8; ++g) { const int ai = g >> 2, m = g & 3, r = row0 + ai * HALF + m * 16;
                const f32x4 c0 = cn0, c1 = cn1, s0 = sn0, s1 = sn1;
                if (g < 7) { const int r2 = row0 + ((g + 1) >> 2) * HALF + ((g + 1) & 3) * 16;
                    cn0 = *(const GAS f32x4*)(ct + (size_t)r2 * 32 + 8 * fq); cn1 = *(const GAS f32x4*)(ct + (size_t)r2 * 32 + 8 * fq + 4);
                    sn0 = *(const GAS f32x4*)(st + (size_t)r2 * 32 + 8 * fq); sn1 = *(const GAS f32x4*)(st + (size_t)r2 * 32 + 8 * fq + 4); }
                const f32x4 a0 = acc[ai][0][m][0], a1 = acc[ai][0][m][1], b0 = acc[ai][1][m][0], b1 = acc[ai][1][m][1];
                const f32x4 o10 = (a0 * c0 - b0 * s0) * sc, o11 = (a1 * c1 - b1 * s1) * sc, o20 = (a0 * s0 + b0 * c0) * sc, o21 = (a1 * s1 + b1 * c1) * sc;
                bf16_t* p = dst + (size_t)(r - row0 + rowS) * AW + head * HD + 8 * fqs;
                st8p(wt, p, o10, o11, pa); st8p(wt, p + 32, o20, o21, pa); }
#endif
        } else if (kind == 4) {
#pragma unroll
            for (int bj = 0; bj < 2; ++bj) { const int col = sub * 256 + bj * HALF + wc * 32 + 8 * fq;
                f32x4 lb0 = (f32x4){0.f, 0.f, 0.f, 0.f}, lb1 = lb0;
                if (layer == 1) { const f32x4 p0 = *(const GAS f32x4*)(lbp + col), p1 = *(const GAS f32x4*)(lbp + col + 4), q0 = *(const GAS f32x4*)(lbp + HW + col), q1 = *(const GAS f32x4*)(lbp + HW + col + 4);
#pragma unroll
                    for (int k = 0; k < 4; ++k) { lb0[k] = __builtin_amdgcn_rcpf(1.f + __expf(p0[k] - q0[k])); lb1[k] = __builtin_amdgcn_rcpf(1.f + __expf(p1[k] - q1[k])); } }
#pragma unroll
                for (int ai = 0; ai < 2; ++ai)
#pragma unroll
                    for (int m = 0; m < 4; ++m) { const int r = row0 + ai * HALF + m * 16; f32x4 g0, g1;
#pragma unroll
                        for (int k = 0; k < 4; ++k) {
#if defined(F0_FAST) && F0_FAST
                            if (layer == 0) { g0[k] = -__logf(1.f + __expf(-acc[ai][bj][m][0][k])); g1[k] = -__logf(1.f + __expf(-acc[ai][bj][m][1][k])); }
                            else
#endif
                            { g0[k] = __logf(lb0[k] + (1.f - lb0[k]) * sigm_f(acc[ai][bj][m][0][k])); g1[k] = __logf(lb1[k] + (1.f - lb1[k]) * sigm_f(acc[ai][bj][m][1][k])); } }
                        st8p(wt, (bf16_t*)GH + (size_t)(r - row0 + rowS) * HW + col - 8 * fq + 8 * fqs, g0, g1, pa); asm volatile("" ::: "memory"); } }
        } else {
            bf16_t* dst = (kind == 2) ? VA : (kind == 3) ? QH : (kind == 5) ? IH : OG;
            #if defined(SIG_IN_MN) && SIG_IN_MN
            const int act = (kind == 3) ? 1 : 0;
#else
            const int act = (kind == 3) ? 1 : (kind == 6) ? 2 : 0;
#endif
#pragma unroll
            for (int ai = 0; ai < 2; ++ai)
#pragma unroll
                for (int m = 0; m < 4; ++m) { const int r = row0 + ai * HALF + m * 16;
#pragma unroll
                    for (int bj = 0; bj < 2; ++bj) { f32x4 v0 = acc[ai][bj][m][0], v1 = acc[ai][bj][m][1];
                        if (act) {
#pragma unroll
                            for (int k = 0; k < 4; ++k) { const float s0 = sigm_f(v0[k]), s1 = sigm_f(v1[k]); v0[k] = (act == 1) ? v0[k] * s0 : s0; v1[k] = (act == 1) ? v1[k] * s1 : s1; } }
                        st8p(wt, dst + (size_t)(r - row0 + rowS) * 512 + sub * 256 + bj * HALF + wc * 32 + 8 * fqs, v0, v1, pa); } }
        }
    }
};

constexpr int RING_OFF = 0, RING_BYTES = 131072;
constexpr int MISC_OFF = RING_BYTES + 320;
constexpr int LDS_BYTES = 147456;

struct Args {
    const float *x, *c; const int* positions; const float *w_in, *w_out, *attn_norm, *hgrn_norm, *lb_params, *ada_w, *ada_b, *w_router, *b_router, *w_gate, *w_up, *w_down, *final_norm;
    float* out; unsigned char* ws; int ph_lo, ph_hi, hybrid, pad;
};
struct Frame {
    LAS unsigned char* lds; volatile LAS unsigned* MISC; gu32* ctl; int tid, lane, wave, G, vcu; unsigned char* ws;
};

__device__ __forceinline__ void transpose_item(const float* W, int ldn, int k0, int col0, bf16_t* WT, int Kd, int drow0, LAS float* scr, int lane) {
    float tv[32];
#pragma unroll
    for (int i = 0; i < 32; ++i) tv[i] = NT_LOAD(((const GAS float*)W) + (size_t)(k0 + 2 * i + (lane >> 5)) * ldn + col0 + (lane & 31));
#pragma unroll
    for (int i = 0; i < 32; ++i) scr[(2 * i + (lane >> 5)) * 33 + (lane & 31)] = tv[i];
    LDS_WAIT(); asm volatile("" ::: "memory");
    const int c = lane & 7;
#pragma unroll
    for (int j = 0; j < 4; ++j) { const int n = (lane >> 3) + 8 * j; const LAS float* s = scr + (8 * c) * 33 + n;
        u32x4 o; o.x = pk2(s[0 * 33], s[1 * 33]); o.y = pk2(s[2 * 33], s[3 * 33]); o.z = pk2(s[4 * 33], s[5 * 33]); o.w = pk2(s[6 * 33], s[7 * 33]);
        *(GAS u32x4*)(WT + (size_t)(drow0 + n) * Kd + k0 + 8 * c) = o; }
    LDS_WAIT(); asm volatile("" ::: "memory");
}
__device__ __forceinline__ int win_src_col(int n0) {
    const int tile = n0 >> 8, rho = n0 & 255;
    if (tile < 4) { const int base = (tile >> 1) * 512, hh = (rho & 127) >> 5, half = rho >> 7; return base + (4 * (tile & 1) + hh) * 64 + 32 * half; }
    return n0;
}
#if defined(P0_CONV) && P0_CONV
constexpr int P0_CONV_ITEMS = 512;
#endif
__device__ __forceinline__ void convert_weights(const Frame& F, const Args& a, int l, int part, int gw_ov = -1, int ngw_ov = 0, int lo_ov = -1, int hi_ov = -1) {
    LAS float* scr = (LAS float*)(F.lds + RING_OFF + F.wave * 16384);
    const int gw = gw_ov >= 0 ? gw_ov : F.vcu * NWAVES + F.wave, NGW = gw_ov >= 0 ? ngw_ov : F.G * NWAVES;
    constexpr int I_IN = 16 * 112, I_OUT = 16 * 32, I_GU = 16 * 32 * NE, I_DN = 8 * 32 * NE;
    bf16_t* Win = (bf16_t*)(F.ws + WS_WIN); bf16_t* Wout = (bf16_t*)(F.ws + WS_WOUT); bf16_t* Wgu = (bf16_t*)(F.ws + WS_WGU); bf16_t* Wd = (bf16_t*)(F.ws + WS_WD);
    const int lo = lo_ov >= 0 ? lo_ov : (part & 1) ? 0 : I_IN + I_OUT, hi = lo_ov >= 0 ? hi_ov : (part & 2) ? I_IN + I_OUT + I_GU + I_DN : I_IN + I_OUT;
    for (int it = lo + gw; it < hi; it += NGW) {
        int r = it;
        if (r < I_IN) { const int kb = r / 112, grp = r % 112; transpose_item(a.w_in + (size_t)l * D * INC, INC, kb * 64, win_src_col(grp * 32), Win, D, grp * 32, scr, F.lane); continue; } r -= I_IN;
        if (r < I_OUT) { const int kb = r / 32, grp = r % 32; transpose_item(a.w_out + (size_t)l * D * D, D, kb * 64, grp * 32, Wout, D, grp * 32, scr, F.lane); continue; } r -= I_OUT;
        if (r < I_GU) { const int e = r / 512, q = r % 512, kb = q / 32, grp = q % 32, drow0 = grp * 32, tile = drow0 >> 8, rho = drow0 & 255;
            const float* src = (rho < 128 ? a.w_gate : a.w_up) + ((size_t)l * NE + e) * D * FF;
            transpose_item(src, FF, kb * 64, 128 * tile + (rho & 127), Wgu + (size_t)e * 1024 * D, D, drow0, scr, F.lane); continue; } r -= I_GU;
        { const int e = r / 256, q = r % 256, kb = q / 32, grp = q % 32;
            transpose_item(a.w_down + ((size_t)l * NE + e) * FF * D, D, kb * 64, grp * 32, Wd + (size_t)e * D * FF, FF, grp * 32, scr, F.lane); }
    }
}
#if defined(ROPE_BF) && ROPE_BF
#define ROPE_STORE(ct_, st_, i_, c_, s_) (((unsigned*)(ct_))[i_] = pk2((c_), (s_)))
#else
#define ROPE_STORE(ct_, st_, i_, c_, s_) do { (ct_)[i_] = (c_); (st_)[i_] = (s_); } while (0)
#endif
__device__ __forceinline__ void p0_prologue(const Frame& F, const Args& a) {
    const int gw = F.vcu * NWAVES + F.wave, NGW = F.G * NWAVES;
    float* adap = (float*)(F.ws + WS_ADAP);
#if defined(PRO_POLISH) && PRO_POLISH
    if (NGW >= DEPTH * 24 * 32) {
        const int it = gw; const bool has = it < DEPTH * 24 * 32;
        const int l = it / (24 * 32), q = it % (24 * 32), cb = q / 32, kc = q % 32, col = cb * 256 + lane_id_asm() * 4;
        f32x4 w[32];
        if (has) { const float* W = a.ada_w + ((size_t)l * D + kc * 32) * 6 * D + col;
#pragma unroll
            for (int k = 0; k < 32; ++k) w[k] = NT_LOAD((const GAS f32x4*)(W + (size_t)k * 6 * D)); }
        { float* ct = (float*)(F.ws + WS_ROPE_C); float* st = (float*)(F.ws + WS_ROPE_S);
          for (int i = F.vcu * NTHR + F.wave * 64 + lane_id_asm(); i < T * 32; i += F.G * NTHR) {
              const int t = i >> 5, j = i & 31;
              const float inv = exp2f(-(float)j * (13.287712379549449f / 32.0f));
              const float ang = (float)a.positions[t] * inv; float sn, cs; sincosf(ang, &sn, &cs);
              ROPE_STORE(ct, st, i, cs, sn); } }
        if (has) {
            f32x4 a0 = (f32x4){0.f, 0.f, 0.f, 0.f}, a1 = a0;
#pragma unroll
            for (int k = 0; k < 32; ++k) { const float c0 = silu_f(a.c[kc * 32 + k]), c1 = silu_f(a.c[D + kc * 32 + k]); a0 += w[k] * c0; a1 += w[k] * c1; }
            *(GAS f32x4*)(adap + (((size_t)l * 32 + kc) * 2 + 0) * 6 * D + col) = a0;
            *(GAS f32x4*)(adap + (((size_t)l * 32 + kc) * 2 + 1) * 6 * D + col) = a1; }
        return;
    }
#endif
    for (int it = gw; it < DEPTH * 24 * 32; it += NGW) {
        const int l = it / (24 * 32), q = it % (24 * 32), cb = q / 32, kc = q % 32, col = cb * 256 + lane_id_asm() * 4;
        const float* W = a.ada_w + ((size_t)l * D + kc * 32) * 6 * D + col;
        f32x4 w[32];
#pragma unroll
        for (int k = 0; k < 32; ++k) w[k] = NT_LOAD((const GAS f32x4*)(W + (size_t)k * 6 * D));
        f32x4 a0 = (f32x4){0.f, 0.f, 0.f, 0.f}, a1 = a0;
#pragma unroll
        for (int k = 0; k < 32; ++k) { const float c0 = silu_f(a.c[kc * 32 + k]), c1 = silu_f(a.c[D + kc * 32 + k]); a0 += w[k] * c0; a1 += w[k] * c1; }
        *(GAS f32x4*)(adap + (((size_t)l * 32 + kc) * 2 + 0) * 6 * D + col) = a0;
        *(GAS f32x4*)(adap + (((size_t)l * 32 + kc) * 2 + 1) * 6 * D + col) = a1;
    }
    float* ct = (float*)(F.ws + WS_ROPE_C); float* st = (float*)(F.ws + WS_ROPE_S);
    for (int i = F.vcu * NTHR + F.wave * 64 + lane_id_asm(); i < T * 32; i += F.G * NTHR) {
        const int t = i >> 5, j = i & 31;
        const float inv = exp2f(-(float)j * (13.287712379549449f / 32.0f));
        const float ang = (float)a.positions[t] * inv; float sn, cs; sincosf(ang, &sn, &cs);
        ROPE_STORE(ct, st, i, cs, sn);
    }
}
__device__ __forceinline__ void p1_prologue(const Frame& F, const Args& a) {
    const float* adap = (const float*)(F.ws + WS_ADAP); float* mod = (float*)(F.ctl + CW_MOD);
#if defined(PRO_POLISH) && PRO_POLISH
    const int per_ = (DEPTH * NB * 6 * D + F.G - 1) / F.G;
    for (int i = F.vcu * per_ + F.tid; i < DEPTH * NB * 6 * D && F.tid < per_; i += F.G * per_) {
#else
    for (int i = F.vcu * NTHR + F.tid; i < DEPTH * NB * 6 * D; i += F.G * NTHR) {
#endif
        const int n = i % (6 * D), b = (i / (6 * D)) % NB, l = i / (NB * 6 * D);
        float p[32];
#pragma unroll
        for (int kc = 0; kc < 32; ++kc) p[kc] = adap[(((size_t)l * 32 + kc) * 2 + b) * 6 * D + n];
        float s = a.ada_b[(size_t)l * 6 * D + n];
#pragma unroll
        for (int kc = 0; kc < 32; ++kc) s += p[kc];
        mod[i] = s;
    }
#if defined(P0_CONV) && P0_CONV
    convert_weights(F, a, 0, 3, -1, 0, P0_CONV_ITEMS, 16 * 112 + 16 * 32 + 16 * 32 * NE + 8 * 32 * NE);
#else
    convert_weights(F, a, 0, 3);
#endif
}
__device__ __forceinline__ void norm_rows(const Frame& F, const float* x, const float* mod_l  , int part  , bf16_t* out) {
    const int gw = F.vcu * NWAVES + F.wave, NGW = F.G * NWAVES;
    if (gw >= T) return;
    f32x4 vn[4];
    { const GAS f32x4* xr = (const GAS f32x4*)(x + (size_t)gw * D) + F.lane;
#pragma unroll
      for (int j = 0; j < 4; ++j) vn[j] = xr[64 * j]; }
#pragma unroll 1
    for (int row = gw; row < T; row += NGW) {
        f32x4 v[4];
#pragma unroll
        for (int j = 0; j < 4; ++j) v[j] = vn[j];
        { const int nrow = (row + NGW < T) ? row + NGW : row; const GAS f32x4* xr = (const GAS f32x4*)(x + (size_t)nrow * D) + F.lane;
#pragma unroll
          for (int j = 0; j < 4; ++j) vn[j] = xr[64 * j]; }
        const float* m = mod_l + (size_t)(row / S) * 6 * D + part * D;
        float ss = 0.f;
#pragma unroll
        for (int j = 0; j < 4; ++j) ss += (v[j].x * v[j].x + v[j].y * v[j].y) + (v[j].z * v[j].z + v[j].w * v[j].w);
        const float r = 1.0f / sqrtf(wave_sum(ss) * (1.f / D) + EPS);
        GAS unsigned long long* o8 = (GAS unsigned long long*)(out + (size_t)row * D) + F.lane;
#pragma unroll
        for (int j = 0; j < 4; ++j) { const f32x4 sh = *((const GAS f32x4*)m + F.lane + 64 * j), sc = *((const GAS f32x4*)(m + D) + F.lane + 64 * j);
            const f32x4 h = v[j] * r * (sc + 1.0f) + sh;
            o8[64 * j] = (unsigned long long)pk2(h.x, h.y) | ((unsigned long long)pk2(h.z, h.w) << 32); }
    }
}
typedef short v4i16_t __attribute__((ext_vector_type(4)));
__device__ __forceinline__ s16x4 vtr(const LAS unsigned char* p) { return __builtin_bit_cast(s16x4, __builtin_amdgcn_ds_read_tr16_b64_v4i16((LAS v4i16_t*)p)); }
__device__ __forceinline__ bf16x8 cat4(s16x4 a, s16x4 b) { return (bf16x8){a[0], a[1], a[2], a[3], b[0], b[1], b[2], b[3]}; }
constexpr int ATT_UNITS = NB * NH * 3 * 32;
struct AttnUnit { int b, h, p, d, r, ub; };
__device__ __forceinline__ void attn_decode(int it, AttnUnit& a) {
#if defined(ATT_ROT) && ATT_ROT
    const int g = (it + (it >> 8)) & 31, p = (it >> 5) % 3, bh = (it >> 5) / 3;
#else
    const int g = it & 31, p = (it >> 5) % 3, bh = (it >> 5) / 3;
#endif
    a.b = bh >> 3; a.h = bh & 7; a.p = p; a.d = (p == 0) ? 1 : (p == 1) ? 4 : 16;
    const int per = 32 / a.d;
    a.r = g / per; a.ub = g % per;
}
__device__ __forceinline__ void attn_phase(const Frame& F) {
    const GAS bf16_t* QA = (const GAS bf16_t*)(F.ws + WS_QA); const GAS bf16_t* KA = (const GAS bf16_t*)(F.ws + WS_KA); const GAS bf16_t* VA = (const GAS bf16_t*)(F.ws + WS_VA);
    GAS bf16_t* PART = (GAS bf16_t*)(F.ws + WS_PART); GAS float* LSE = (GAS float*)(F.ws + WS_LSE);
    LAS unsigned char* img = F.lds + RING_OFF;
    const int lane = F.lane, w = F.wave, tid = F.tid;
    const int qi = lane & 31, hf = lane >> 5;
    const int kroff = qi * 128, kswz = (qi & 2) << 1;
    const int tq = (lane & 15) >> 2, tp = lane & 3, tg = (lane >> 4) & 1, tsw = (tq & 2) << 1;
    const int trb0 = (4 * hf + tq) * 128 + (((2 * tg + (tp >> 1)) ^ tsw) * 16) + 8 * (tp & 1);
    const int trb1 = (4 * hf + tq) * 128 + (((4 + 2 * tg + (tp >> 1)) ^ tsw) * 16) + 8 * (tp & 1);
    int it = F.vcu;
    if (it >= ATT_UNITS) return;
    AttnUnit cur; attn_decode(it, cur);
    bf16x8 kr[6], vr[6];
#define ATT_FETCH(U) do { _Pragma("unroll") for (int i_ = 0; i_ < 6; ++i_) { const int q_ = tid + NTHR * i_, key_ = q_ >> 3, ch_ = q_ & 7; int pos_ = 256 * (U).ub - 128 + key_; pos_ = pos_ < 0 ? 0 : pos_; \
        const size_t row_ = (size_t)(U).b * S + (size_t)pos_ * (U).d + (U).r; kr[i_] = *(const GAS bf16x8*)(KA + row_ * AW + (U).h * HD + ch_ * 8); vr[i_] = *(const GAS bf16x8*)(VA + row_ * AW + (U).h * HD + ch_ * 8); } } while (0)
#define ATT_PUT() do { _Pragma("unroll") for (int i_ = 0; i_ < 6; ++i_) { const int q_ = tid + NTHR * i_, key_ = q_ >> 3, ch_ = q_ & 7, row_ = key_ & 31; \
        LAS unsigned char* d_ = img + (key_ >> 5) * 8192 + row_ * 128 + ((ch_ ^ ((row_ & 2) << 1)) * 16); *(LAS bf16x8*)d_ = kr[i_]; *(LAS bf16x8*)(d_ + 4096) = vr[i_]; } } while (0)
    ATT_FETCH(cur);
    bf16x8 qf[4];
    { const GAS bf16x8* qp = (const GAS bf16x8*)(QA + ((size_t)cur.b * S + (size_t)(256 * cur.ub + 32 * w + qi) * cur.d + cur.r) * AW + cur.h * HD + 32 * hf);
#pragma unroll
      for (int ks = 0; ks < 4; ++ks) qf[ks] = qp[ks]; }
    ATT_PUT();
    __syncthreads();
    for (;;) {
        const int nit = it + F.G; const bool more = nit < ATT_UNITS;
        AttnUnit nx = cur; if (more) attn_decode(nit, nx);
        ATT_FETCH(nx);
        bf16x8 nq[4];
        { const GAS bf16x8* qp = (const GAS bf16x8*)(QA + ((size_t)nx.b * S + (size_t)(256 * nx.ub + 32 * w + qi) * nx.d + nx.r) * AW + nx.h * HD + 32 * hf);
#pragma unroll
          for (int ks = 0; ks < 4; ++ks) nq[ks] = qp[ks]; }
        const int U0 = 256 * cur.ub + 32 * w;
        const size_t rowq = (size_t)cur.b * S + (size_t)(U0 + qi) * cur.d + cur.r;
        const int kb0 = (U0 >= 128) ? 0 : ((128 - U0) >> 5);
        float zz = 0.f; asm volatile("" : "+v"(zz));
        f32x16 o0, o1;
#pragma unroll
        for (int i = 0; i < 16; ++i) { o0[i] = zz; o1[i] = zz; }
        float m = -INFINITY, l = 0.f;
#pragma unroll
        for (int kb = 0; kb < 5; ++kb) {
            if (kb >= kb0) {
            const LAS unsigned char* kimg = img + (w + kb) * 8192; const LAS unsigned char* vimg = kimg + 4096;
            f32x16 s;
#pragma unroll
            for (int i = 0; i < 16; ++i) s[i] = 0.f;
#pragma unroll
            for (int ks = 0; ks < 4; ++ks) { const bf16x8 kf = *(const LAS bf16x8*)(kimg + kroff + (((4 * hf + ks) ^ kswz) * 16)); s = __builtin_amdgcn_mfma_f32_32x32x16_bf16(kf, qf[ks], s, 0, 0, 0); }
            if (kb == 0) {
#pragma unroll
                for (int i = 0; i < 16; ++i) { const int kk = (i & 3) + 8 * (i >> 2) + 4 * hf; if (kk < qi) s[i] = -INFINITY; }
            }
            if (kb == 4) {
#pragma unroll
                for (int i = 0; i < 16; ++i) { const int kk = (i & 3) + 8 * (i >> 2) + 4 * hf; if (kk > qi) s[i] = -INFINITY; }
            }
            float mx = s[0];
#pragma unroll
            for (int i = 1; i < 16; ++i) mx = fmaxf(mx, s[i]);
            mx = fmaxf(mx, __builtin_bit_cast(float, __builtin_amdgcn_ds_bpermute((lane ^ 32) << 2, __builtin_bit_cast(int, mx))));
            const float mn = fmaxf(m, mx), alpha = __builtin_amdgcn_exp2f(m - mn);
            m = mn;
            float rs = 0.f;
#pragma unroll
            for (int i = 0; i < 16; ++i) { s[i] = __builtin_amdgcn_exp2f(s[i] - mn); rs += s[i]; }
            l = l * alpha + rs;
            if (__builtin_amdgcn_ballot_w64(alpha != 1.0f) != 0) {
#pragma unroll
                for (int i = 0; i < 16; ++i) { o0[i] *= alpha; o1[i] *= alpha; }
            }
            bf16x8 pf[2];
#pragma unroll
            for (int s2 = 0; s2 < 2; ++s2) {
                u32x4 wv; wv.x = cvt_pk_bf16(s[8 * s2 + 0], s[8 * s2 + 1]); wv.y = cvt_pk_bf16(s[8 * s2 + 2], s[8 * s2 + 3]); wv.z = cvt_pk_bf16(s[8 * s2 + 4], s[8 * s2 + 5]); wv.w = cvt_pk_bf16(s[8 * s2 + 6], s[8 * s2 + 7]);
                pf[s2] = __builtin_bit_cast(bf16x8, wv);
            }
#pragma unroll
            for (int s2 = 0; s2 < 2; ++s2) {
                const bf16x8 v0 = cat4(vtr(vimg + trb0 + (16 * s2) * 128), vtr(vimg + trb0 + (16 * s2 + 8) * 128));
                const bf16x8 v1 = cat4(vtr(vimg + trb1 + (16 * s2) * 128), vtr(vimg + trb1 + (16 * s2 + 8) * 128));
                o0 = __builtin_amdgcn_mfma_f32_32x32x16_bf16(v0, pf[s2], o0, 0, 0, 0);
                o1 = __builtin_amdgcn_mfma_f32_32x32x16_bf16(v1, pf[s2], o1, 0, 0, 0);
            }
            }
        }
        l += __builtin_bit_cast(float, __builtin_amdgcn_ds_bpermute((lane ^ 32) << 2, __builtin_bit_cast(int, l)));
        const float inv = 1.0f / l;
#if defined(BR_FP8) && (BR_FP8 & 1)
        GAS unsigned char* op = (GAS unsigned char*)PART + (size_t)cur.p * T * AW + rowq * AW + cur.h * HD + 4 * hf;
#pragma unroll
        for (int c = 0; c < 4; ++c) {
            int w0 = __builtin_amdgcn_cvt_pk_fp8_f32(F8SAT(o0[4 * c] * inv), F8SAT(o0[4 * c + 1] * inv), 0, false); w0 = __builtin_amdgcn_cvt_pk_fp8_f32(F8SAT(o0[4 * c + 2] * inv), F8SAT(o0[4 * c + 3] * inv), w0, true);
            int w1 = __builtin_amdgcn_cvt_pk_fp8_f32(F8SAT(o1[4 * c] * inv), F8SAT(o1[4 * c + 1] * inv), 0, false); w1 = __builtin_amdgcn_cvt_pk_fp8_f32(F8SAT(o1[4 * c + 2] * inv), F8SAT(o1[4 * c + 3] * inv), w1, true);
            *(GAS int*)(op + 8 * c) = w0; *(GAS int*)(op + 32 + 8 * c) = w1;
        }
#else
        GAS bf16_t* op = PART + (size_t)cur.p * T * AW + rowq * AW + cur.h * HD + 4 * hf;
#pragma unroll
        for (int c = 0; c < 4; ++c) {
            u32x2 w0, w1;
            w0.x = cvt_pk_bf16(o0[4 * c] * inv, o0[4 * c + 1] * inv); w0.y = cvt_pk_bf16(o0[4 * c + 2] * inv, o0[4 * c + 3] * inv);
            w1.x = cvt_pk_bf16(o1[4 * c] * inv, o1[4 * c + 1] * inv); w1.y = cvt_pk_bf16(o1[4 * c + 2] * inv, o1[4 * c + 3] * inv);
            *(GAS u32x2*)(op + 8 * c) = w0; *(GAS u32x2*)(op + 32 + 8 * c) = w1;
        }
#endif
        if (hf == 0) LSE[(size_t)cur.p * T * NH + rowq * NH + cur.h] = m + __builtin_amdgcn_logf(l);
        if (!more) break;
        __syncthreads();
        ATT_PUT();
#pragma unroll
        for (int ks = 0; ks < 4; ++ks) qf[ks] = nq[ks];
        __syncthreads();
        cur = nx; it = nit;
    }
#undef ATT_FETCH
#undef ATT_PUT
    __syncthreads();
}
constexpr size_t WS_EREF = WS_DEC + 512 * 1024;
#if defined(HG_WIDE) && HG_WIDE
__device__ __forceinline__ void hgrn_tile_to_lds(const bf16_t* __restrict__ P, size_t row0, int h, int lane, LAS unsigned char* scr) {
    const GAS bf16x8* gp = (const GAS bf16x8*)((const GAS bf16_t*)P + (row0 + (lane >> 3)) * HW + h * 64) + (lane & 7);
    bf16x8 t[8];
#pragma unroll
    for (int j = 0; j < 8; ++j) t[j] = gp[(size_t)j * (8 * HW / 8)];
#pragma unroll
    for (int j = 0; j < 8; ++j) *(LAS bf16x8*)(scr + ((lane >> 3) + 8 * j) * 128 + (lane & 7) * 16) = t[j];
    LDS_WAIT(); asm volatile("" ::: "memory");
}
#endif
__device__ __forceinline__ void hgrn_load_gates(const float* __restrict__ GH, size_t row0, int h, int lane, float (&bc)[64], float (&kf)[64], LAS unsigned char* scr) {
#if defined(HG_WIDE) && HG_WIDE
    hgrn_tile_to_lds((const bf16_t*)GH, row0, h, lane, scr);
#pragma unroll
    for (int s = 0; s < 64; ++s) bc[s] = bf2f(*(const LAS unsigned short*)(scr + s * 128 + lane * 2));
    LDS_WAIT(); asm volatile("" ::: "memory");
#else
    const GAS bf16_t* gp = (const GAS bf16_t*)GH + row0 * HW + h * 64 + lane;
#pragma unroll
    for (int s = 0; s < 64; ++s) bc[s] = bf2f(gp[(size_t)s * HW]);
#endif
#pragma unroll
    for (int s = 0; s < 64; ++s) kf[s] = 1.0f - __expf(bc[s]);
#pragma unroll
    for (int s = 1; s < 64; ++s) bc[s] += bc[s - 1];
}
__device__ __forceinline__ void hgrn_v_image(const bf16_t* __restrict__ IH, size_t row0, int h, int lane, LAS unsigned char* img) {
    const GAS bf16x8* vp = (const GAS bf16x8*)(IH + (row0 + lane) * HW + h * 64);
    bf16x8 v[8];
#pragma unroll
    for (int c = 0; c < 8; ++c) v[c] = vp[c];
#pragma unroll
    for (int c = 0; c < 8; ++c) *(LAS bf16x8*)(img + (c >> 2) * 4096 + lane * 64 + (c & 3) * 16) = v[c];
}
__device__ __forceinline__ void hgrn_local(const Frame& F, int u) {
    const int lane = opqv(F.lane), h = u & 7, bn = u >> 3; const size_t row0 = (size_t)bn * 64;
    LAS unsigned char* kimg = F.lds + RING_OFF + F.wave * 16384; LAS unsigned char* vimg = kimg + 8192;
    float bc[64], kf[64];
    hgrn_load_gates((const float*)(F.ws + WS_GH), row0, h, lane, bc, kf, kimg);
    const float b63 = bc[63];
    ((GAS float*)(F.ws + WS_DEC))[(size_t)u * 64 + lane] = __expf(b63);
    ((GAS float*)(F.ws + WS_EREF))[(size_t)u * 64 + lane] = __expf(bc[31]);
#pragma unroll
    for (int s = 0; s < 64; ++s) *(LAS unsigned short*)(kimg + (lane >> 5) * 4096 + s * 64 + (lane & 31) * 2) = (unsigned short)cvt1_bf16(kf[s] * __expf(b63 - bc[s]));
    hgrn_v_image((const bf16_t*)(F.ws + WS_IH), row0, h, lane, vimg);
    const int hf = lane >> 5;
    const int trb = (8 * hf + ((lane & 15) >> 2)) * 64 + (((lane >> 4) & 1) * 16 + (lane & 3) * 4) * 2;
    float zz = 0.f; asm volatile("" : "+v"(zz));
    f32x16 acc[2][2];
#pragma unroll
    for (int a = 0; a < 2; ++a)
#pragma unroll
        for (int c = 0; c < 2; ++c)
#pragma unroll
            for (int i = 0; i < 16; ++i) acc[a][c][i] = zz;
#pragma unroll
    for (int st = 0; st < 4; ++st) {
        bf16x8 av[2], bk[2];
#pragma unroll
        for (int x = 0; x < 2; ++x) { av[x] = cat4(vtr(vimg + x * 4096 + trb + st * 1024), vtr(vimg + x * 4096 + trb + st * 1024 + 256));
                                      bk[x] = cat4(vtr(kimg + x * 4096 + trb + st * 1024), vtr(kimg + x * 4096 + trb + st * 1024 + 256)); }
#pragma unroll
        for (int db = 0; db < 2; ++db)
#pragma unroll
            for (int cb = 0; cb < 2; ++cb) acc[db][cb] = __builtin_amdgcn_mfma_f32_32x32x16_bf16(av[db], bk[cb], acc[db][cb], 0, 0, 0);
    }
    GAS bf16_t* sl = (GAS bf16_t*)(F.ws + WS_SLOC) + (size_t)u * 4096;
#pragma unroll
    for (int db = 0; db < 2; ++db)
#pragma unroll
        for (int cb = 0; cb < 2; ++cb)
#pragma unroll
            for (int i = 0; i < 16; ++i) sl[((i & 3) + 8 * (i >> 2) + 4 * hf + 32 * db) * 64 + (lane & 31) + 32 * cb] = (bf16_t)cvt1_bf16(acc[db][cb][i]);
}
__device__ __forceinline__ void hgrn_local_phase(const Frame& F) {
    const int gw = F.vcu * NWAVES + F.wave, NGW = F.G * NWAVES;
    for (int u = gw; u < NB * 128 * NH; u += NGW) hgrn_local(F, u);
}
__device__ __forceinline__ void hgrn_scan_phase(const Frame& F) {
    GAS unsigned* SL = (GAS unsigned*)(F.ws + WS_SLOC); const GAS float* DEC = (const GAS float*)(F.ws + WS_DEC); const GAS float* ER = (const GAS float*)(F.ws + WS_EREF);
    if ((int)blockIdx.x >= (int)gridDim.x / 2)
    for (int id = ((int)blockIdx.x - (int)gridDim.x / 2) * NTHR + F.tid; id < NB * NH * 2048; id += ((int)gridDim.x - (int)gridDim.x / 2) * NTHR) {
        const int bh = id >> 11, vk2 = id & 2047, b = bh >> 3, h = bh & 7, k = (2 * vk2) & 63;
        float st0 = 0.f, st1 = 0.f;
        for (int n0 = 0; n0 < 128; n0 += 16) {
            unsigned cur[16]; f32x2 dd[16], er[16];
#pragma unroll
            for (int j = 0; j < 16; ++j) { const size_t u = (size_t)(b * 128 + n0 + j) * 8 + h; cur[j] = SL[u * 2048 + vk2]; dd[j] = *(const GAS f32x2*)(DEC + u * 64 + k); er[j] = *(const GAS f32x2*)(ER + u * 64 + k); }
#pragma unroll
            for (int j = 0; j < 16; ++j) { const size_t u = (size_t)(b * 128 + n0 + j) * 8 + h;
                SL[u * 2048 + vk2] = cvt_pk_bf16(st0 * er[j].x, st1 * er[j].y);
                st0 = dd[j].x * st0 + bflo(cur[j]); st1 = dd[j].y * st1 + bfhi(cur[j]); }
        }
    }
}
__device__ __forceinline__ void hgrn_out(const Frame& F, int u) {
    const int lane = opqv(F.lane), h = u & 7, bn = u >> 3; const size_t row0 = (size_t)bn * 64;
    LAS unsigned char* qimg = F.lds + RING_OFF + F.wave * 16384; LAS unsigned char* kimg = qimg + 8192;
    {
        float bc[64], kf[64];
        hgrn_load_gates((const float*)(F.ws + WS_GH), row0, h, lane, bc, kf, kimg);
        const float bref = bc[31];
#if defined(HG_WIDE) && HG_WIDE
        hgrn_tile_to_lds((const bf16_t*)(F.ws + WS_QH), row0, h, lane, qimg);
#else
        const GAS bf16_t* qp = (const GAS bf16_t*)(F.ws + WS_QH) + row0 * HW + h * 64 + lane;
#endif
#pragma unroll
        for (int s = 0; s < 64; ++s) {
#if defined(HG_WIDE) && HG_WIDE
            const float qv = bf2f(*(const LAS unsigned short*)(qimg + s * 128 + lane * 2));
#else
            const float qv = bf2f(qp[(size_t)s * HW]);
#endif
            *(LAS unsigned short*)(qimg + s * 128 + lane * 2) = (unsigned short)cvt1_bf16(qv * __expf(bc[s] - bref));
            *(LAS unsigned short*)(kimg + s * 128 + lane * 2) = (unsigned short)cvt1_bf16(kf[s] * __expf(bref - bc[s]));
        }
    }
    const int r32 = lane & 31, hf = lane >> 5;
    bf16x8 qf[2][4];
#pragma unroll
    for (int tb = 0; tb < 2; ++tb)
#pragma unroll
        for (int ks = 0; ks < 4; ++ks) qf[tb][ks] = *(const LAS bf16x8*)(qimg + (32 * tb + r32) * 128 + hf * 64 + ks * 16);
    float zz = 0.f; asm volatile("" : "+v"(zz));
    f32x16 a00, a01, a11;
#pragma unroll
    for (int i = 0; i < 16; ++i) { a00[i] = zz; a01[i] = zz; a11[i] = zz; }
#pragma unroll
    for (int ks = 0; ks < 4; ++ks) {
        const bf16x8 k0 = *(const LAS bf16x8*)(kimg + r32 * 128 + hf * 64 + ks * 16), k1 = *(const LAS bf16x8*)(kimg + (32 + r32) * 128 + hf * 64 + ks * 16);
        a00 = __builtin_amdgcn_mfma_f32_32x32x16_bf16(k0, qf[0][ks], a00, 0, 0, 0);
        a01 = __builtin_amdgcn_mfma_f32_32x32x16_bf16(k0, qf[1][ks], a01, 0, 0, 0);
        a11 = __builtin_amdgcn_mfma_f32_32x32x16_bf16(k1, qf[1][ks], a11, 0, 0, 0);
    }
#pragma unroll
    for (int i = 0; i < 16; ++i) { const int sl = (i & 3) + 8 * (i >> 2) + 4 * hf; if (sl > r32) { a00[i] = zz; a11[i] = zz; } }
    f32x16 o[2][2];
#pragma unroll
    for (int a = 0; a < 2; ++a)
#pragma unroll
        for (int c = 0; c < 2; ++c)
#pragma unroll
            for (int i = 0; i < 16; ++i) o[a][c][i] = zz;
    const bf16_t* sp = (const bf16_t*)(F.ws + WS_SLOC) + (size_t)u * 4096;
#pragma unroll
    for (int db = 0; db < 2; ++db)
#pragma unroll
        for (int ks = 0; ks < 4; ++ks) {
            const bf16x8 sf = *(const GAS bf16x8*)(sp + (32 * db + r32) * 64 + 32 * hf + 8 * ks);
            o[db][0] = __builtin_amdgcn_mfma_f32_32x32x16_bf16(sf, qf[0][ks], o[db][0], 0, 0, 0);
            o[db][1] = __builtin_amdgcn_mfma_f32_32x32x16_bf16(sf, qf[1][ks], o[db][1], 0, 0, 0);
        }
    LAS unsigned char* vimg = qimg;
    hgrn_v_image((const bf16_t*)(F.ws + WS_IH), row0, h, lane, vimg);
    const int trb = (4 * hf + ((lane & 15) >> 2)) * 64 + (((lane >> 4) & 1) * 16 + (lane & 3) * 4) * 2;
#pragma unroll
    for (int s2 = 0; s2 < 2; ++s2) {
        u32x4 w;
        w.x = cvt_pk_bf16(a00[8 * s2 + 0], a00[8 * s2 + 1]); w.y = cvt_pk_bf16(a00[8 * s2 + 2], a00[8 * s2 + 3]); w.z = cvt_pk_bf16(a00[8 * s2 + 4], a00[8 * s2 + 5]); w.w = cvt_pk_bf16(a00[8 * s2 + 6], a00[8 * s2 + 7]);
        const bf16x8 p00 = __builtin_bit_cast(bf16x8, w);
        w.x = cvt_pk_bf16(a01[8 * s2 + 0], a01[8 * s2 + 1]); w.y = cvt_pk_bf16(a01[8 * s2 + 2], a01[8 * s2 + 3]); w.z = cvt_pk_bf16(a01[8 * s2 + 4], a01[8 * s2 + 5]); w.w = cvt_pk_bf16(a01[8 * s2 + 6], a01[8 * s2 + 7]);
        const bf16x8 p01 = __builtin_bit_cast(bf16x8, w);
        w.x = cvt_pk_bf16(a11[8 * s2 + 0], a11[8 * s2 + 1]); w.y = cvt_pk_bf16(a11[8 * s2 + 2], a11[8 * s2 + 3]); w.z = cvt_pk_bf16(a11[8 * s2 + 4], a11[8 * s2 + 5]); w.w = cvt_pk_bf16(a11[8 * s2 + 6], a11[8 * s2 + 7]);
        const bf16x8 p11 = __builtin_bit_cast(bf16x8, w);
#pragma unroll
        for (int db = 0; db < 2; ++db) {
            const LAS unsigned char* t0 = vimg + db * 4096 + trb + (16 * s2) * 64;
            const bf16x8 v0 = cat4(vtr(t0), vtr(t0 + 512));
            const bf16x8 v1 = cat4(vtr(t0 + 2048), vtr(t0 + 2048 + 512));
            o[db][0] = __builtin_amdgcn_mfma_f32_32x32x16_bf16(v0, p00, o[db][0], 0, 0, 0);
            o[db][1] = __builtin_amdgcn_mfma_f32_32x32x16_bf16(v0, p01, o[db][1], 0, 0, 0);
            o[db][1] = __builtin_amdgcn_mfma_f32_32x32x16_bf16(v1, p11, o[db][1], 0, 0, 0);
        }
    }
#if defined(BR_FP8) && (BR_FP8 & 2)
    unsigned char* rp = (unsigned char*)(F.ws + WS_REC);
#pragma unroll
    for (int tb = 0; tb < 2; ++tb) { unsigned char* op = rp + (row0 + 32 * tb + r32) * HW + h * 64 + 4 * hf;
#pragma unroll
        for (int db = 0; db < 2; ++db)
#pragma unroll
            for (int c = 0; c < 4; ++c) { int w = __builtin_amdgcn_cvt_pk_fp8_f32(F8SAT(o[db][tb][4 * c]), F8SAT(o[db][tb][4 * c + 1]), 0, false); w = __builtin_amdgcn_cvt_pk_fp8_f32(F8SAT(o[db][tb][4 * c + 2]), F8SAT(o[db][tb][4 * c + 3]), w, true); *(GAS int*)(op + 32 * db + 8 * c) = w; } }
#else
    bf16_t* rp = (bf16_t*)(F.ws + WS_REC);
#pragma unroll
    for (int tb = 0; tb < 2; ++tb) { bf16_t* op = rp + (row0 + 32 * tb + r32) * HW + h * 64 + 4 * hf;
#pragma unroll
        for (int db = 0; db < 2; ++db)
#pragma unroll
            for (int c = 0; c < 4; ++c) { u32x2 w; w.x = cvt_pk_bf16(o[db][tb][4 * c], o[db][tb][4 * c + 1]); w.y = cvt_pk_bf16(o[db][tb][4 * c + 2], o[db][tb][4 * c + 3]); *(GAS u32x2*)(op + 32 * db + 8 * c) = w; } }
#endif
}
__device__ __forceinline__ void hgrn_out_phase(const Frame& F) {
    const int gw = F.vcu * NWAVES + F.wave, NGW = F.G * NWAVES;
    for (int u = gw; u < NB * 128 * NH; u += NGW) hgrn_out(F, u);
}
__device__ __forceinline__ void merge_phase(const Frame& F, const float* attn_norm_l, const float* hgrn_norm_l) {
    const bf16_t* PART = (const bf16_t*)(F.ws + WS_PART); const float* LSE = (const float*)(F.ws + WS_LSE);
    const bf16_t* REC = (const bf16_t*)(F.ws + WS_REC); const bf16_t* OG = (const bf16_t*)(F.ws + WS_OG); bf16_t* HB = (bf16_t*)(F.ws + WS_HB);
    const int gw = F.vcu * NWAVES + F.wave, NGW = F.G * NWAVES, lane = F.lane, hd = lane >> 3;
    const f32x4 an0 = *(const GAS f32x4*)(attn_norm_l + lane * 8), an1 = *(const GAS f32x4*)(attn_norm_l + lane * 8 + 4);
    const f32x4 hn0 = *(const GAS f32x4*)(hgrn_norm_l + lane * 8), hn1 = *(const GAS f32x4*)(hgrn_norm_l + lane * 8 + 4);
    if (gw >= T) return;
#if defined(BR_FP8) && (BR_FP8 & 1)
    typedef u32x2 mrg_p_t;
#define MRG_PLD(base_, rw_) (*(const GAS u32x2*)((const GAS unsigned char*)PART + (base_) + (size_t)(rw_) * AW + lane * 8))
#else
    typedef u32x4 mrg_p_t;
#define MRG_PLD(base_, rw_) (*(const GAS u32x4*)(PART + (base_) + (size_t)(rw_) * AW + lane * 8))
#endif
#if defined(BR_FP8) && (BR_FP8 & 2)
    typedef u32x2 mrg_r_t;
#define MRG_RLD(rw_) (*(const GAS u32x2*)((const GAS unsigned char*)REC + (size_t)(rw_) * HW + lane * 8))
#else
    typedef u32x4 mrg_r_t;
#define MRG_RLD(rw_) (*(const GAS u32x4*)(REC + (size_t)(rw_) * HW + lane * 8))
#endif
    mrg_p_t n0, n1, n2; mrg_r_t nr; u32x4 ng; float nl0, nl1, nl2;
#define MRG_LOAD(rw) do { nl0 = ((const GAS float*)LSE)[(size_t)(rw) * NH + hd]; nl1 = ((const GAS float*)LSE)[(size_t)T * NH + (size_t)(rw) * NH + hd]; nl2 = ((const GAS float*)LSE)[(size_t)2 * T * NH + (size_t)(rw) * NH + hd]; \
        n0 = MRG_PLD((size_t)0, rw); n1 = MRG_PLD((size_t)T * AW, rw); n2 = MRG_PLD((size_t)2 * T * AW, rw); nr = MRG_RLD(rw); ng = *(const GAS u32x4*)(OG + (size_t)(rw) * HW + lane * 8); } while (0)
#define MRG_UNP8(o_, w_) do { o_[0] = __builtin_amdgcn_cvt_f32_fp8((int)(w_).x, 0); o_[1] = __builtin_amdgcn_cvt_f32_fp8((int)(w_).x, 1); o_[2] = __builtin_amdgcn_cvt_f32_fp8((int)(w_).x, 2); o_[3] = __builtin_amdgcn_cvt_f32_fp8((int)(w_).x, 3); \
        o_[4] = __builtin_amdgcn_cvt_f32_fp8((int)(w_).y, 0); o_[5] = __builtin_amdgcn_cvt_f32_fp8((int)(w_).y, 1); o_[6] = __builtin_amdgcn_cvt_f32_fp8((int)(w_).y, 2); o_[7] = __builtin_amdgcn_cvt_f32_fp8((int)(w_).y, 3); } while (0)
#define MRG_UNP16(o_, w_) do { _Pragma("unroll") for (int j_ = 0; j_ < 4; ++j_) { o_[2 * j_] = bflo((w_)[j_]); o_[2 * j_ + 1] = bfhi((w_)[j_]); } } while (0)
#if defined(BR_FP8) && (BR_FP8 & 1)
#define MRG_UNPP MRG_UNP8
#else
#define MRG_UNPP MRG_UNP16
#endif
#if defined(BR_FP8) && (BR_FP8 & 2)
#define MRG_UNPR MRG_UNP8
#else
#define MRG_UNPR MRG_UNP16
#endif
    MRG_LOAD(gw);
#pragma unroll 1
    for (int row = gw; row < T; row += NGW) {
        const float l0 = nl0, l1 = nl1, l2 = nl2; const mrg_p_t p0 = n0, p1 = n1, p2 = n2; const mrg_r_t rr = nr; const u32x4 gg = ng;
        { const int nrow = (row + NGW < T) ? row + NGW : row; MRG_LOAD(nrow); }
        const float lm = fmaxf(l0, fmaxf(l1, l2));
        float w0 = __builtin_amdgcn_exp2f(l0 - lm), w1 = __builtin_amdgcn_exp2f(l1 - lm), w2 = __builtin_amdgcn_exp2f(l2 - lm);
        const float wi = __builtin_amdgcn_rcpf(w0 + w1 + w2); w0 *= wi; w1 *= wi; w2 *= wi;
        float a[8], r[8], g[8]; float sa = 0.f, sr = 0.f;
        float q0[8], q1[8], q2[8];
        MRG_UNPP(q0, p0); MRG_UNPP(q1, p1); MRG_UNPP(q2, p2); MRG_UNPR(r, rr);
#pragma unroll
        for (int j = 0; j < 4; ++j) {
            a[2 * j] = w0 * q0[2 * j] + w1 * q1[2 * j] + w2 * q2[2 * j]; a[2 * j + 1] = w0 * q0[2 * j + 1] + w1 * q1[2 * j + 1] + w2 * q2[2 * j + 1];
#if defined(SIG_IN_MN) && SIG_IN_MN
            g[2 * j] = sigm_f(bflo(gg[j])); g[2 * j + 1] = sigm_f(bfhi(gg[j]));
#else
            g[2 * j] = bflo(gg[j]); g[2 * j + 1] = bfhi(gg[j]);
#endif
        }
#pragma unroll
        for (int j = 0; j < 8; ++j) { sa += a[j] * a[j]; sr += r[j] * r[j]; }
        const float ra = __builtin_amdgcn_rsqf(wave_sum(sa) * (1.f / AW) + EPS), rq = __builtin_amdgcn_rsqf(wave_sum(sr) * (1.f / HW) + EPS);
        u32x4 oa, orr;
        oa.x = pk2(a[0] * ra * an0[0], a[1] * ra * an0[1]); oa.y = pk2(a[2] * ra * an0[2], a[3] * ra * an0[3]); oa.z = pk2(a[4] * ra * an1[0], a[5] * ra * an1[1]); oa.w = pk2(a[6] * ra * an1[2], a[7] * ra * an1[3]);
        orr.x = pk2(r[0] * rq * hn0[0] * g[0], r[1] * rq * hn0[1] * g[1]); orr.y = pk2(r[2] * rq * hn0[2] * g[2], r[3] * rq * hn0[3] * g[3]);
        orr.z = pk2(r[4] * rq * hn1[0] * g[4], r[5] * rq * hn1[1] * g[5]); orr.w = pk2(r[6] * rq * hn1[2] * g[6], r[7] * rq * hn1[3] * g[7]);
        *(GAS u32x4*)(HB + (size_t)row * D + lane * 8) = oa; *(GAS u32x4*)(HB + (size_t)row * D + AW + lane * 8) = orr;
    }
#undef MRG_LOAD
}
__device__ __forceinline__ void bf8_to_f32(u32x4 w, f32x4& lo, f32x4& hi) { lo = (f32x4){bflo(w.x), bfhi(w.x), bflo(w.y), bfhi(w.y)}; hi = (f32x4){bflo(w.z), bfhi(w.z), bflo(w.w), bfhi(w.w)}; }
#if defined(EPI_HOIST) && (EPI_HOIST & 1)
template <bool SRC_F32>
#endif
struct EpiOut {
    static constexpr bool PROBE2 = false;
    static constexpr bool PERM = true;
#if defined(OUT16) && OUT16
    static constexpr bool PERM16 = true;
#define EPO_CB 8
#define EPO_C0(wc_, fq_) ((wc_) * 64 + 16 * (fq_))
#else
    static constexpr bool PERM16 = false;
#define EPO_CB HALF
#define EPO_C0(wc_, fq_) ((wc_) * 32 + 8 * (fq_))
#endif
    const float* xf; const bf16_t* xb; bf16_t* xout; const float* g1; bool src_f32; WtBuf wt;
    __device__ __forceinline__ void operator()(const f32x4 (&acc)[2][2][4][2], const GUnit& u, int wr, int wc, int fr, int fq) const {
        const int row0 = u.pm * BM + wr * 64 + fr, col0 = u.pn * BM + EPO_C0(wc, fq), b = (u.pm * BM) / S;
        f32x4 gv[2][2];
#pragma unroll
        for (int bj = 0; bj < 2; ++bj)
#pragma unroll
            for (int n = 0; n < 2; ++n) gv[bj][n] = *(const GAS f32x4*)(g1 + (size_t)b * 6 * D + col0 + bj * EPO_CB + 4 * n);
#if defined(EPI_HOIST) && (EPI_HOIST & 1)
#define EPO_STORES() do { _Pragma("unroll") for (int ai = 0; ai < 2; ++ai) _Pragma("unroll") for (int m = 0; m < 4; ++m) _Pragma("unroll") for (int bj = 0; bj < 2; ++bj) \
            st8w(wt, xout + (size_t)(row0 + ai * HALF + m * 16) * D + col0 + bj * EPO_CB, o[ai][bj][m][0], o[ai][bj][m][1]); } while (0)
        if (SRC_F32) {
            f32x4 o[2][2][4][2];
#pragma unroll
            for (int q = 0; q < 4; ++q) { const int ai = q >> 1, mb = (q & 1) * 2;
                f32x4 xr[2][2][2];
#pragma unroll
                for (int mm = 0; mm < 2; ++mm)
#pragma unroll
                    for (int bj = 0; bj < 2; ++bj) { const size_t o_ = (size_t)(row0 + ai * HALF + (mb + mm) * 16) * D + col0 + bj * EPO_CB; xr[mm][bj][0] = *(const GAS f32x4*)(xf + o_); xr[mm][bj][1] = *(const GAS f32x4*)(xf + o_ + 4); }
#pragma unroll
                for (int mm = 0; mm < 2; ++mm)
#pragma unroll
                    for (int bj = 0; bj < 2; ++bj)
#pragma unroll
                        for (int n = 0; n < 2; ++n) o[ai][bj][mb + mm][n] = xr[mm][bj][n] + gv[bj][n] * acc[ai][bj][mb + mm][n];
                asm volatile("" ::: "memory"); __builtin_amdgcn_sched_barrier(0);
            }
            EPO_STORES();
        } else {
            f32x4 o[2][2][4][2];
#pragma unroll
            for (int ai = 0; ai < 2; ++ai) {
                u32x4 xr[4][2];
#pragma unroll
                for (int m = 0; m < 4; ++m)
#pragma unroll
                    for (int bj = 0; bj < 2; ++bj) xr[m][bj] = *(const GAS u32x4*)(xb + (size_t)(row0 + ai * HALF + m * 16) * D + col0 + bj * EPO_CB);
#pragma unroll
                for (int m = 0; m < 4; ++m)
#pragma unroll
                    for (int bj = 0; bj < 2; ++bj) { f32x4 x0, x1; bf8_to_f32(xr[m][bj], x0, x1); o[ai][bj][m][0] = x0 + gv[bj][0] * acc[ai][bj][m][0]; o[ai][bj][m][1] = x1 + gv[bj][1] * acc[ai][bj][m][1]; }
                asm volatile("" ::: "memory"); __builtin_amdgcn_sched_barrier(0);
            }
            EPO_STORES();
        }
#undef EPO_STORES
#else
        f32x4 xn[2][2];
#define EPO_LOAD(rw) do { _Pragma("unroll") for (int bj_ = 0; bj_ < 2; ++bj_) { const size_t o_ = (size_t)(rw) * D + col0 + bj_ * EPO_CB; \
            if (src_f32) { xn[bj_][0] = *(const GAS f32x4*)(xf + o_); xn[bj_][1] = *(const GAS f32x4*)(xf + o_ + 4); } else { bf8_to_f32(*(const GAS u32x4*)(xb + o_), xn[bj_][0], xn[bj_][1]); } } } while (0)
        EPO_LOAD(row0);
#pragma unroll
        for (int g = 0; g < 8; ++g) { const int ai = g >> 2, m = g & 3, row = row0 + ai * HALF + m * 16;
            f32x4 xc[2][2];
#pragma unroll
            for (int bj = 0; bj < 2; ++bj)
#pragma unroll
                for (int n = 0; n < 2; ++n) xc[bj][n] = xn[bj][n];
            if (g < 7) { const int r2 = row0 + ((g + 1) >> 2) * HALF + ((g + 1) & 3) * 16; EPO_LOAD(r2); }
#pragma unroll
            for (int bj = 0; bj < 2; ++bj) st8w(wt, xout + (size_t)row * D + col0 + bj * EPO_CB, xc[bj][0] + gv[bj][0] * acc[ai][bj][m][0], xc[bj][1] + gv[bj][1] * acc[ai][bj][m][1]);
        }
#undef EPO_LOAD
#endif
    }
};

__device__ __forceinline__ void route_lane(const float (&lgs)[NE], LAS int* lcnt, LAS int* sel, int lrow) {
    float mx = lgs[0];
#pragma unroll
    for (int e = 1; e < NE; ++e) mx = fmaxf(mx, lgs[e]);
    float pr[NE];
#pragma unroll
    for (int e = 0; e < NE; ++e) pr[e] = __expf(lgs[e] - mx);
    int gs = 0, i1 = 0, i2 = 0; float best = -1.f, v1 = 0.f, v2 = 0.f;
#pragma unroll
    for (int g = 0; g < 4; ++g) { float m1 = -1.f, m2 = -1.f; int j1 = 0, j2 = 0;
#pragma unroll
        for (int i = 0; i < 4; ++i) { const float pv = pr[g * 4 + i]; if (pv > m1) { m2 = m1; j2 = j1; m1 = pv; j1 = i; } else if (pv > m2) { m2 = pv; j2 = i; } }
        const float sg = m1 + m2; if (sg > best) { best = sg; gs = g; v1 = m1; v2 = m2; i1 = j1; i2 = j2; } }
    const float wsum = v1 + v2; const int e1 = gs * 4 + i1, e2 = gs * 4 + i2;
    const int p1 = atomicAdd((int*)(lcnt + e1), 1), p2 = atomicAdd((int*)(lcnt + e2), 1);
    sel[lrow * 4 + 0] = e1 | (e2 << 8) | (p1 << 16) | (p2 << 24); sel[lrow * 4 + 1] = __builtin_bit_cast(int, v1 / wsum); sel[lrow * 4 + 2] = __builtin_bit_cast(int, v2 / wsum);
}
constexpr int RT_HSTR = 1028;
#if defined(RT_DEFER) && RT_DEFER
constexpr int RT_HS = 0, RT_PART = 16 * RT_HSTR * 4, RT_SEL = RT_PART + 4 * 8 * 256 * 4, RT_LCNT = RT_SEL + 64 * 16, RT_END = RT_LCNT + 128;
#else
constexpr int RT_HS = 0, RT_PART = 16 * RT_HSTR * 4, RT_SEL = RT_PART + 8 * 256 * 4, RT_LCNT = RT_SEL + 64 * 16, RT_END = RT_LCNT + 128;
#endif
static_assert(RT_END <= RING_BYTES, "router LDS map");
__device__ __forceinline__ void router_phase(const Frame& F, const bf16_t* x1, const float* mod_l, const float* w_router, const float* b_router, int layer, bool junk = false) {
    LAS float* Hs = (LAS float*)(F.lds + RING_OFF + RT_HS);
    LAS float* Pp = (LAS float*)(F.lds + RING_OFF + RT_PART);
    LAS int* sel = (LAS int*)(F.lds + RING_OFF + RT_SEL);
    LAS int* lcnt = (LAS int*)(F.lds + RING_OFF + RT_LCNT);
    bf16_t* HB = (bf16_t*)(F.ws + WS_HB); int* cntb = (int*)(F.ws + (junk ? WS_PART : WS_CNTB)); int* selg = (int*)(F.ws + (junk ? WS_PART + 2 * MiB : WS_SELG));
    const int lane = F.lane, w = F.wave, fr = lane & 15, fq = lane >> 4;
    float breg[32];
#pragma unroll
    for (int ks = 0; ks < 32; ++ks) breg[ks] = ((const GAS float*)w_router)[(size_t)(128 * w + 4 * ks + fq) * NE + fr];
    const float bias = ((const GAS float*)b_router)[fr];
    for (int blk = F.vcu; blk < T / 64; blk += F.G) {
        if (F.tid < 16) lcnt[F.tid] = 0;
        const float* m = mod_l + (size_t)((blk * 64) / S) * 6 * D + 3 * D;
        f32x4 shv[4], scv[4];
#pragma unroll
        for (int j = 0; j < 2; ++j) { const int k0 = 8 * lane + 512 * j;
            shv[2 * j] = *(const GAS f32x4*)(m + k0); shv[2 * j + 1] = *(const GAS f32x4*)(m + k0 + 4); scv[2 * j] = *(const GAS f32x4*)(m + D + k0) + 1.0f; scv[2 * j + 1] = *(const GAS f32x4*)(m + D + k0 + 4) + 1.0f; }
        u32x4 vn[2][2];
        { const GAS u32x4* xr = (const GAS u32x4*)(x1 + (size_t)(blk * 64 + 2 * w) * D) + lane; vn[0][0] = xr[0]; vn[0][1] = xr[64]; vn[1][0] = xr[128]; vn[1][1] = xr[192]; }
#pragma unroll 1
        for (int q = 0; q < 4; ++q) {
            u32x4 vc[2][2];
#pragma unroll
            for (int i = 0; i < 2; ++i) { vc[i][0] = vn[i][0]; vc[i][1] = vn[i][1]; }
            { const int nq = q < 3 ? q + 1 : q; const GAS u32x4* xr = (const GAS u32x4*)(x1 + (size_t)(blk * 64 + 16 * nq + 2 * w) * D) + lane; vn[0][0] = xr[0]; vn[0][1] = xr[64]; vn[1][0] = xr[128]; vn[1][1] = xr[192]; }
#pragma unroll
            for (int i = 0; i < 2; ++i) {
                const int hr = 2 * w + i, row = blk * 64 + 16 * q + hr;
                f32x4 v[4];
                bf8_to_f32(vc[i][0], v[0], v[1]); bf8_to_f32(vc[i][1], v[2], v[3]);
                float ss = 0.f;
#pragma unroll
                for (int j = 0; j < 4; ++j) ss += (v[j].x * v[j].x + v[j].y * v[j].y) + (v[j].z * v[j].z + v[j].w * v[j].w);
                const float r = 1.0f / sqrtf(wave_sum(ss) * (1.f / D) + EPS);
                GAS u32x4* o8 = (GAS u32x4*)(HB + (size_t)row * D) + lane;
#pragma unroll
                for (int j = 0; j < 2; ++j) {
                    const f32x4 h0 = v[2 * j] * r * scv[2 * j] + shv[2 * j], h1 = v[2 * j + 1] * r * scv[2 * j + 1] + shv[2 * j + 1];
                    u32x4 w8; w8.x = pk2(h0.x, h0.y); w8.y = pk2(h0.z, h0.w); w8.z = pk2(h1.x, h1.y); w8.w = pk2(h1.z, h1.w); o8[64 * j] = w8;
                    LAS float* hp = Hs + hr * RT_HSTR + 8 * lane + 512 * j; *(LAS f32x4*)hp = h0; *(LAS f32x4*)(hp + 4) = h1;
                }
            }
            __syncthreads();
#if defined(RT_ILP) && RT_ILP
            f32x4 acc;
            { const LAS float* ap = Hs + fr * RT_HSTR + 128 * w + fq;
              f32x4 a4[4];
#pragma unroll
              for (int c = 0; c < 4; ++c) a4[c] = (f32x4){0.f, 0.f, 0.f, 0.f};
#pragma unroll
              for (int ks = 0; ks < 32; ++ks) a4[ks & 3] = __builtin_amdgcn_mfma_f32_16x16x4f32(ap[4 * ks], breg[ks], a4[ks & 3], 0, 0, 0);
              acc = (a4[0] + a4[1]) + (a4[2] + a4[3]); }
#else
            f32x4 acc = (f32x4){0.f, 0.f, 0.f, 0.f};
            { const LAS float* ap = Hs + fr * RT_HSTR + 128 * w + fq;
#pragma unroll
              for (int ks = 0; ks < 32; ++ks) acc = __builtin_amdgcn_mfma_f32_16x16x4f32(ap[4 * ks], breg[ks], acc, 0, 0, 0); }
#endif
#pragma unroll
#if defined(RT_DEFER) && RT_DEFER
            for (int i = 0; i < 4; ++i) Pp[q * 2048 + w * 256 + (4 * fq + i) * 16 + fr] = acc[i];
            __syncthreads();
            if (false) {
#else
            for (int i = 0; i < 4; ++i) Pp[w * 256 + (4 * fq + i) * 16 + fr] = acc[i];
            __syncthreads();
            if (w == 0) {
#endif
                float lgs[NE];
                if (lane < 16) {
#pragma unroll
                    for (int e = 0; e < NE; ++e) { float s = 0.f;
#pragma unroll
                        for (int ww = 0; ww < 8; ++ww) s += Pp[ww * 256 + lane * 16 + e];
                        lgs[e] = s + __builtin_bit_cast(float, __builtin_amdgcn_readlane(__builtin_bit_cast(int, bias), e)); }
                    route_lane(lgs, lcnt, sel, 16 * q + lane);
                }
            }
        }
        __syncthreads();
#if defined(RT_DEFER) && RT_DEFER
        if (w == 0) {
            float lgs[NE]; const int q_ = lane >> 4, r_ = lane & 15;
#pragma unroll
            for (int e = 0; e < NE; ++e) { float s = 0.f;
#pragma unroll
                for (int ww = 0; ww < 8; ++ww) s += Pp[q_ * 2048 + ww * 256 + r_ * 16 + e];
                lgs[e] = s + __builtin_bit_cast(float, __builtin_amdgcn_readlane(__builtin_bit_cast(int, bias), e)); }
            route_lane(lgs, lcnt, sel, lane);
        }
        __syncthreads();
#endif
#if defined(RT_ATOMIC) && RT_ATOMIC
        { LAS int* lbase = lcnt + 16;
          unsigned* cntg = (unsigned*)(F.ctl + CW_CNT + layer * 1024); int* listg = (int*)(F.ws + WS_LIST); float* pwg = (float*)(F.ws + WS_PW);
          if (F.tid < 16) lbase[F.tid] = (int)__hip_atomic_fetch_add((GAS unsigned*)cntg + 64 * F.tid, (unsigned)lcnt[F.tid], __ATOMIC_RELAXED, __HIP_MEMORY_SCOPE_AGENT);
          __syncthreads();
          if (F.tid < 128) { const int lrow = F.tid >> 1, slot = F.tid & 1, row = blk * 64 + lrow; const int pk = sel[lrow * 4];
              const int e = (pk >> (8 * slot)) & 0xff, lp = (pk >> (16 + 8 * slot)) & 0xff; const size_t at = (size_t)e * T + lbase[e] + lp;
              ((GAS int*)listg)[at] = row * 2 + slot; ((GAS float*)pwg)[at] = __builtin_bit_cast(float, sel[lrow * 4 + 1 + slot]); }
          __syncthreads(); }
#else
        if (F.tid < 16) ((GAS int*)cntb)[blk * 16 + F.tid] = lcnt[F.tid];
        if (F.tid < 64) { ((GAS int*)selg)[(blk * 64 + F.tid) * 4 + 0] = sel[F.tid * 4 + 0]; ((GAS int*)selg)[(blk * 64 + F.tid) * 4 + 1] = sel[F.tid * 4 + 1]; ((GAS int*)selg)[(blk * 64 + F.tid) * 4 + 2] = sel[F.tid * 4 + 2]; }
        __syncthreads();
#endif
    }
    __syncthreads();
}
__device__ __forceinline__ void scatter_phase(const Frame& F, int layer) {
    LAS int* cl = (LAS int*)(F.lds + RING_OFF);
    LAS int* part = cl + 256 * 16;
    LAS int* lbase = part + 256;
    const int* cntb = (const int*)(F.ws + WS_CNTB); const int* selg = (const int*)(F.ws + WS_SELG);
    int* list = (int*)(F.ws + WS_LIST); float* pw = (float*)(F.ws + WS_PW); unsigned* cnt = (unsigned*)(F.ctl + CW_CNT + layer * 1024);
    {   int t[8];
#pragma unroll
        for (int j = 0; j < 8; ++j) t[j] = cntb[F.tid + NTHR * j];
#pragma unroll
        for (int j = 0; j < 8; ++j) cl[F.tid + NTHR * j] = t[j]; }
    __syncthreads();
    if (F.tid < 256) { const int e = F.tid & 15, ch = F.tid >> 4; int s = 0;
#pragma unroll
        for (int j = 0; j < 16; ++j) s += cl[(ch * 16 + j) * 16 + e];
        part[ch * 16 + e] = s; }
    __syncthreads();
    for (int blk = F.vcu; blk < T / 64; blk += F.G) {
        if (F.tid < 16) { const int e = F.tid; int run = 0;
            for (int ch = 0; ch < 16; ++ch) { if (ch == (blk >> 4)) { int b2 = run; for (int j = 0; j < (blk & 15); ++j) b2 += cl[((blk & ~15) + j) * 16 + e]; lbase[e] = b2; } run += part[ch * 16 + e]; }
            if (blk == 0) cnt[64 * e] = (unsigned)run; }
        __syncthreads();
        if (F.tid < 128) { const int lrow = F.tid >> 1, slot = F.tid & 1, row = blk * 64 + lrow; const int pk = selg[(blk * 64 + lrow) * 4];
            const int e = (pk >> (8 * slot)) & 0xff, lp = (pk >> (16 + 8 * slot)) & 0xff; const size_t at = (size_t)e * T + lbase[e] + lp;
            list[at] = row * 2 + slot; pw[at] = __builtin_bit_cast(float, selg[(blk * 64 + lrow) * 4 + 1 + slot]); }
        __syncthreads();
    }
    __syncthreads();
}

__device__ __forceinline__ int moe_deal_t(const Frame& F, int l) {
    const unsigned* cnt = (const unsigned*)(F.ctl + CW_CNT + l * 1024); int tt = 0;
#pragma unroll
    for (int j = 0; j < NE; ++j) { const int cj = (int)__builtin_amdgcn_readfirstlane(__hip_atomic_load((const GAS unsigned*)cnt + 64 * j, __ATOMIC_RELAXED, __HIP_MEMORY_SCOPE_AGENT)); tt += (cj + 255) >> 8; }
    const int t = 4 * tt - 2 * F.G;
    return (F.G == 256 && t > 0 && t <= 51) ? t : -1;
}
template <int MODE> struct MoeOrder {
    static constexpr int mode = MODE; static constexpr bool gather = (MODE == 0);
    const char* A; const char* Bt; const unsigned* cnt; const int* list; int K, G, c; size_t bstride; unsigned* ready; unsigned* tmo;
#if defined(CNT_CACHE) && CNT_CACHE
    int cjs[NE];
    __device__ __forceinline__ void load_counts() {
#pragma unroll
        for (int j = 0; j < NE; ++j) cjs[j] = (int)__builtin_amdgcn_readfirstlane(__hip_atomic_load((const GAS unsigned*)cnt + 64 * j, __ATOMIC_RELAXED, __HIP_MEMORY_SCOPE_AGENT)); }
#define MOE_CJ(j) cjs[j]
#else
    __device__ __forceinline__ void load_counts() {}
#define MOE_CJ(j) ((int)__builtin_amdgcn_readfirstlane(__hip_atomic_load((const GAS unsigned*)cnt + 64 * (j), __ATOMIC_RELAXED, __HIP_MEMORY_SCOPE_AGENT)))
#endif
    __device__ __forceinline__ int total_units() const { int t = 0;
#pragma unroll
        for (int j = 0; j < NE; ++j) { const int cj = MOE_CJ(j); t += (cj + 255) >> 8; }
        return 4 * t; }
    __device__ __forceinline__ int deal(int i, int U) const {
        const int t = U - 2 * G;
        if (G != 256 || t <= 0 || t > 51) { const int L = i * G + c; return L < U ? L : -1; }
        const int a = 3 * t, b = G - 5 * t;
        if (mode == 0) {
            if (i == 0) return c;
            if (i == 1) return c < a + b ? G + c : -1;
            if (i == 2) return c < a ? G + a + b + c : -1;
            return -1;
        }
        if (c < a) return i == 0 ? 2 * G - 2 * t + c : -1;
        if (c < a + b) return i < 2 ? 8 * t + i * b + (c - a) : -1;
        return i < 4 ? i * 2 * t + (c - a - b) : -1;
    }
    __device__ __forceinline__ bool next(int i, GUnit& u) const {
        int tt = 0;
        int e = -1, tb = 0, ro = 0, ce = 0, tacc = 0, racc = 0;
#pragma unroll
        for (int j = 0; j < NE; ++j) { const int cj = MOE_CJ(j); tt += (cj + 255) >> 8; }
        const int L = deal(i, 4 * tt);
        if (L < 0) return false;
        const int rt = L >> 2;
#pragma unroll
        for (int j = 0; j < NE; ++j) { const int cj = MOE_CJ(j); const int tj = (cj + 255) >> 8;
            if (rt >= tacc && rt < tacc + tj) { e = j; tb = tacc; ro = racc; ce = cj; } tacc += tj; racc += cj; }
        if (e < 0) return false;
        u.e = e; u.row0 = (rt - tb) * BM; u.nrows = (ce - u.row0) < BM ? (ce - u.row0) : BM; u.pm = ro + u.row0; u.pn = L & 3; u.rtg = rt;
        u.B = Bt + (size_t)e * bstride + (size_t)u.pn * BM * K * 2;
        u.A = gather ? A : A + (size_t)u.pm * K * 2;
        return true;
    }
    __device__ __forceinline__ int arow(const GUnit& u, int r) const { const unsigned rr = r < u.nrows ? (unsigned)r : 0u; const GAS int* lp = (const GAS int*)list + ((size_t)u.e * T + u.row0); return lp[rr] >> 1; }
    struct Early { unsigned pv; int ok, pending; };
    __device__ __forceinline__ void early_reset(Early& st) const { st.pv = 0u; st.ok = 0; st.pending = 0; }
    __device__ __forceinline__ void a_early(const GUnit& u, Early& st) const {
#if defined(EARLY_ACQ) && EARLY_ACQ
        if (mode == 0) return;
        if (__builtin_amdgcn_readfirstlane((int)(threadIdx.x >> 6)) == 0) {
            if (st.pending && !st.ok) { unsigned v; asm volatile("v_readfirstlane_b32 %0, %1" : "=s"(v) : "v"(st.pv)); if (v >= 32u) { asm volatile("buffer_inv sc1" ::: "memory"); st.ok = 1; } }
            if (!st.ok) { const GAS unsigned* rp = (const GAS unsigned*)ready + 64 * u.rtg; asm volatile("global_load_dword %0, %1, off sc1" : "=v"(st.pv) : "v"(rp) : "memory"); st.pending = 1; }
        }
#endif
    }
    __device__ __forceinline__ void a_ready(const GUnit& u0, int idx, Early& st) const {
        if (mode == 0) return;
#if defined(EARLY_ACQ) && EARLY_ACQ
        const bool done = st.ok != 0; early_reset(st);
        if (done) { asm volatile("" ::: "memory"); __builtin_amdgcn_s_barrier(); asm volatile("" ::: "memory"); return; }
#endif
#if defined(ACQ_ONCE) && ACQ_ONCE
        if (idx > 0) return;
#endif
        if (threadIdx.x < 64) {
            unsigned polls = 0;
#if defined(ACQ_ONCE) && ACQ_ONCE
            for (int i = 0; i < 6; ++i) { GUnit u; if (!next(i, u)) break;
#else
            { const GUnit& u = u0;
#endif
            while ((unsigned)__builtin_amdgcn_readfirstlane(__hip_atomic_load((const GAS unsigned*)ready + 64 * u.rtg, __ATOMIC_RELAXED, __HIP_MEMORY_SCOPE_AGENT)) < 32u) {
                if ((++polls & 255u) == 0u) { if (__builtin_amdgcn_readfirstlane(__hip_atomic_load(tmo, __ATOMIC_RELAXED, __HIP_MEMORY_SCOPE_AGENT)) != 0u) break;
                    if (polls > (1u << 20)) { if (threadIdx.x == 0) __hip_atomic_store(tmo, 1u, __ATOMIC_RELAXED, __HIP_MEMORY_SCOPE_AGENT); break; } }
                __builtin_amdgcn_s_sleep(2); }
            }
            __builtin_amdgcn_fence(__ATOMIC_ACQUIRE, "agent");
            asm volatile("s_waitcnt vmcnt(0)" ::: "memory");
        }
        asm volatile("" ::: "memory"); __builtin_amdgcn_s_barrier(); asm volatile("" ::: "memory");
    }
};
struct EpiGateUp {
    static constexpr bool PROBE2 = false;
    static constexpr bool PERM = true;
    static constexpr bool PERM16 = false;
    bf16_t* H; unsigned* ready; WtBuf wt;
    __device__ __forceinline__ void operator()(const f32x4 (&acc)[2][2][4][2], const GUnit& u, int wr, int wc, int fr_, int fq_) const {
        const int fr = opqv(fr_), fq = opqv(fq_);
#pragma unroll
        for (int ai = 0; ai < 2; ++ai)
#pragma unroll
            for (int m = 0; m < 4; ++m) { const int r = ai * HALF + wr * 64 + m * 16 + fr;
                if (r < u.nrows) { f32x4 h0, h1;
#pragma unroll
                    for (int k = 0; k < 4; ++k) { h0[k] = silu_f(acc[ai][0][m][0][k]) * acc[ai][1][m][0][k]; h1[k] = silu_f(acc[ai][0][m][1][k]) * acc[ai][1][m][1][k]; }
                    u32x4 hv; hv.x = cvt_pk_bf16(h0[0], h0[1]); hv.y = cvt_pk_bf16(h0[2], h0[3]); hv.z = cvt_pk_bf16(h1[0], h1[1]); hv.w = cvt_pk_bf16(h1[2], h1[3]);
                    __builtin_amdgcn_raw_buffer_store_b128(hv, wt.rs, (int)(unsigned)((const unsigned char*)(H + (size_t)(u.pm + r) * FF + u.pn * HALF + wc * 32 + 8 * fq) - wt.base), 0, 16); } }
        asm volatile("s_waitcnt vmcnt(0)" ::: "memory");
        if (fr == 0 && fq == 0) __hip_atomic_fetch_add((GAS unsigned*)ready + 64 * u.rtg, 1u, __ATOMIC_RELAXED, __HIP_MEMORY_SCOPE_AGENT);
    }
};
struct EpiDown {
    static constexpr bool PROBE2 = false;
    static constexpr bool PERM = true;
#if defined(Y_FP8) && Y_FP8
    static constexpr bool PERM16 = true;
#else
    static constexpr bool PERM16 = false;
#endif
    bf16_t* Y; const int* list; const float* pw; WtBuf wt;
    __device__ __forceinline__ void operator()(const f32x4 (&acc)[2][2][4][2], const GUnit& u, int wr, int wc, int fr, int fq) const {
        int ent[8]; float wv[8];
#pragma unroll
        for (int g = 0; g < 8; ++g) { const int r = (g >> 2) * HALF + wr * 64 + (g & 3) * 16 + fr, rr = r < u.nrows ? r : 0;
            ent[g] = ((const GAS int*)list)[(size_t)u.e * T + u.row0 + rr]; wv[g] = ((const GAS float*)pw)[(size_t)u.e * T + u.row0 + rr]; }
#if defined(Y_FP8) && Y_FP8
        unsigned char* Y8 = (unsigned char*)Y;
#pragma unroll
        for (int g = 0; g < 8; ++g) { const int ai = g >> 2, m = g & 3, r = ai * HALF + wr * 64 + m * 16 + fr;
            if (r < u.nrows) { const float w = wv[g];
                unsigned char* yp = Y8 + ((size_t)(ent[g] & 1) * T + (ent[g] >> 1)) * D + u.pn * BM + wc * 64 + 16 * fq;
                u32x4 o;
#pragma unroll
                for (int q = 0; q < 4; ++q) { const f32x4 v = acc[ai][q >> 1][m][q & 1] * w; int d_ = __builtin_amdgcn_cvt_pk_fp8_f32(F8SAT(v[0]), F8SAT(v[1]), 0, false); d_ = __builtin_amdgcn_cvt_pk_fp8_f32(F8SAT(v[2]), F8SAT(v[3]), d_, true); o[q] = (unsigned)d_; }
                wt_store16(wt, yp, o); } }
#else
#pragma unroll
        for (int g = 0; g < 8; ++g) { const int ai = g >> 2, m = g & 3, r = ai * HALF + wr * 64 + m * 16 + fr;
            if (r < u.nrows) { const float w = wv[g];
                bf16_t* yp = Y + ((size_t)(ent[g] & 1) * T + (ent[g] >> 1)) * D + u.pn * BM + wc * 32 + 8 * fq;
#pragma unroll
                for (int bj = 0; bj < 2; ++bj) {
#if defined(Y_FP8_TEST)
                    f32x4 q0 = acc[ai][bj][m][0] * w, q1 = acc[ai][bj][m][1] * w;
                    { int a_ = __builtin_amdgcn_cvt_pk_fp8_f32(q0[0], q0[1], 0, false); a_ = __builtin_amdgcn_cvt_pk_fp8_f32(q0[2], q0[3], a_, true);
                      int b_ = __builtin_amdgcn_cvt_pk_fp8_f32(q1[0], q1[1], 0, false); b_ = __builtin_amdgcn_cvt_pk_fp8_f32(q1[2], q1[3], b_, true);
                      q0[0] = __builtin_amdgcn_cvt_f32_fp8(a_, 0); q0[1] = __builtin_amdgcn_cvt_f32_fp8(a_, 1); q0[2] = __builtin_amdgcn_cvt_f32_fp8(a_, 2); q0[3] = __builtin_amdgcn_cvt_f32_fp8(a_, 3);
                      q1[0] = __builtin_amdgcn_cvt_f32_fp8(b_, 0); q1[1] = __builtin_amdgcn_cvt_f32_fp8(b_, 1); q1[2] = __builtin_amdgcn_cvt_f32_fp8(b_, 2); q1[3] = __builtin_amdgcn_cvt_f32_fp8(b_, 3); }
                    st8w(wt, yp + bj * HALF, q0, q1);
#else
                    st8w(wt, yp + bj * HALF, acc[ai][bj][m][0] * w, acc[ai][bj][m][1] * w);
#endif
                } } }
#endif
    }
};
template <bool FINAL>
__device__ __forceinline__ void combine_phase(const Frame& F, float* outf, const float* g2  , const float* nmod  ) {
    const bf16_t* Y = (const bf16_t*)(F.ws + WS_Y); bf16_t* HB = (bf16_t*)(F.ws + WS_HB); bf16_t* XB = (bf16_t*)(F.ws + WS_XB);
    const int gw = F.vcu * NWAVES + F.wave, NGW = F.G * NWAVES, lane = F.lane;
    if (gw >= T) return;
#if defined(Y_FP8) && Y_FP8
    u32x4 xn[2]; u32x2 an[2], cn[2];
#define CMB_LOAD(rw) do { const GAS u32x4* xr_ = (const GAS u32x4*)(XB + (size_t)(rw) * D) + lane; const GAS u32x2* y0_ = (const GAS u32x2*)((const unsigned char*)Y + (size_t)(rw) * D) + lane; \
        const GAS u32x2* y1_ = (const GAS u32x2*)((const unsigned char*)Y + ((size_t)T + (rw)) * D) + lane; \
        xn[0] = xr_[0]; xn[1] = xr_[64]; an[0] = y0_[0]; an[1] = y0_[64]; cn[0] = y1_[0]; cn[1] = y1_[64]; } while (0)
#define CMB_Y(w_, lo_, hi_) do { lo_ = (f32x4){__builtin_amdgcn_cvt_f32_fp8((int)(w_).x, 0), __builtin_amdgcn_cvt_f32_fp8((int)(w_).x, 1), __builtin_amdgcn_cvt_f32_fp8((int)(w_).x, 2), __builtin_amdgcn_cvt_f32_fp8((int)(w_).x, 3)}; \
        hi_ = (f32x4){__builtin_amdgcn_cvt_f32_fp8((int)(w_).y, 0), __builtin_amdgcn_cvt_f32_fp8((int)(w_).y, 1), __builtin_amdgcn_cvt_f32_fp8((int)(w_).y, 2), __builtin_amdgcn_cvt_f32_fp8((int)(w_).y, 3)}; } while (0)
#else
    u32x4 xn[2], an[2], cn[2];
#define CMB_LOAD(rw) do { const GAS u32x4* xr_ = (const GAS u32x4*)(XB + (size_t)(rw) * D) + lane; const GAS u32x4* y0_ = (const GAS u32x4*)(Y + (size_t)(rw) * D) + lane; const GAS u32x4* y1_ = (const GAS u32x4*)(Y + ((size_t)T + (rw)) * D) + lane; \
        xn[0] = xr_[0]; xn[1] = xr_[64]; an[0] = y0_[0]; an[1] = y0_[64]; cn[0] = y1_[0]; cn[1] = y1_[64]; } while (0)
#define CMB_Y(w_, lo_, hi_) bf8_to_f32(w_, lo_, hi_)
#endif
    CMB_LOAD(gw);
#pragma unroll 1
    for (int row = gw; row < T; row += NGW) {
        const int b = row / S;
        f32x4 v[4]; float ss = 0.f;
        {   f32x4 x0, x1, x2, x3, a0, a1, a2, a3, c0, c1, c2, c3;
            bf8_to_f32(xn[0], x0, x1); bf8_to_f32(xn[1], x2, x3); CMB_Y(an[0], a0, a1); CMB_Y(an[1], a2, a3); CMB_Y(cn[0], c0, c1); CMB_Y(cn[1], c2, c3);
            { const int nrow = (row + NGW < T) ? row + NGW : row; CMB_LOAD(nrow); }
            const float* gp = g2 + (size_t)b * 6 * D + 8 * lane;
            v[0] = x0 + *(const GAS f32x4*)(gp) * (a0 + c0); v[1] = x1 + *(const GAS f32x4*)(gp + 4) * (a1 + c1); v[2] = x2 + *(const GAS f32x4*)(gp + 512) * (a2 + c2); v[3] = x3 + *(const GAS f32x4*)(gp + 516) * (a3 + c3); }
#pragma unroll
        for (int j = 0; j < 4; ++j) ss += (v[j].x * v[j].x + v[j].y * v[j].y) + (v[j].z * v[j].z + v[j].w * v[j].w);
        const float r = 1.0f / sqrtf(wave_sum(ss) * (1.f / D) + EPS);
        if (FINAL) {
            float* op = outf + (size_t)row * D + 8 * lane;
#pragma unroll
            for (int j = 0; j < 2; ++j) { const f32x4 f0 = *(const GAS f32x4*)(nmod + 8 * lane + 512 * j), f1 = *(const GAS f32x4*)(nmod + 8 * lane + 512 * j + 4);
                *(GAS f32x4*)(op + 512 * j) = v[2 * j] * r * f0; *(GAS f32x4*)(op + 512 * j + 4) = v[2 * j + 1] * r * f1; }
        } else {
            const float* m = nmod + (size_t)b * 6 * D + 8 * lane;
            GAS u32x4* xw = (GAS u32x4*)(XB + (size_t)row * D) + lane; GAS u32x4* o8 = (GAS u32x4*)(HB + (size_t)row * D) + lane;
#pragma unroll
            for (int j = 0; j < 2; ++j) { const f32x4 va = v[2 * j], vb = v[2 * j + 1];
                u32x4 wx; wx.x = pk2(va.x, va.y); wx.y = pk2(va.z, va.w); wx.z = pk2(vb.x, vb.y); wx.w = pk2(vb.z, vb.w); xw[64 * j] = wx;
                const f32x4 sh0 = *(const GAS f32x4*)(m + 512 * j), sh1 = *(const GAS f32x4*)(m + 512 * j + 4), sc0 = *(const GAS f32x4*)(m + D + 512 * j), sc1 = *(const GAS f32x4*)(m + D + 512 * j + 4);
                const f32x4 h0 = va * r * (sc0 + 1.0f) + sh0, h1 = vb * r * (sc1 + 1.0f) + sh1;
                u32x4 wh; wh.x = pk2(h0.x, h0.y); wh.y = pk2(h0.z, h0.w); wh.z = pk2(h1.x, h1.y); wh.w = pk2(h1.z, h1.w); o8[64 * j] = wh; }
        }
    }
#undef CMB_LOAD
#undef CMB_Y
}
#ifndef REPMASK
#define REPMASK 0
#endif
constexpr int NPH = 23;
#define PH_L(l, k) (2 + 10 * (l) + (k))

__global__ void __launch_bounds__(NTHR, 2) mk_fwd(Args args) {
    extern __shared__ __attribute__((aligned(16))) unsigned char lds_raw[];
    Frame F;
    F.lds = (LAS unsigned char*)lds_raw;
    F.MISC = (volatile LAS unsigned*)(F.lds + MISC_OFF);
    F.tid = threadIdx.x; F.lane = F.tid & 63; F.wave = __builtin_amdgcn_readfirstlane(F.tid >> 6);
    F.G = gridDim.x; { const int bx = blockIdx.x; F.vcu = (F.G % 8 == 0) ? (bx % 8) * (F.G / 8) + bx / 8 : bx; }
    F.ws = args.ws; F.ctl = (gu32*)(args.ws + WS_CTL);
    for (int u = F.tid; u < (LDS_BYTES - RING_BYTES) / 4; u += NTHR) ((LAS unsigned*)(F.lds + RING_BYTES))[u] = 0u;
    __syncthreads();
    (void)xcd_barrier_post((unsigned*)(F.ctl + CW_BAR), F.MISC + 8);
    const int lo = args.ph_lo, hi = args.ph_hi;
#define IN(k) (lo <= (k) && (k) < hi)
    const int vcu0 = F.vcu, wave0 = F.wave;
#define PH_ENTER() do { F.lane = lane_id_asm(); F.wave = opqs(wave0); F.tid = F.wave * 64 + F.lane; F.ws = opq(args.ws); F.ctl = (gu32*)F.ws; F.vcu = opqs(vcu0); } while (0)
#define SEAM(k) do { if (IN(k) && IN((k) + 1)) { XcdBarrier b2_; b2_.bar = (unsigned*)((gu32*)opq(args.ws) + CW_BAR); b2_.x = xb_xcc_id(); b2_.st = (volatile LAS unsigned*)(F.lds + MISC_OFF) + 8; xcd_barrier(b2_); } } while (0)

#if defined(P0_CONV) && P0_CONV
    if (IN(0)) { PH_ENTER(); p0_prologue(F, args);
        { PH_ENTER(); const int gw_ = F.vcu * NWAVES + F.wave, nad_ = DEPTH * 24 * 32;
          if (gw_ >= nad_ && F.G * NWAVES > nad_) convert_weights(F, args, 0, 3, gw_ - nad_, F.G * NWAVES - nad_, 0, P0_CONV_ITEMS); else if (F.G * NWAVES <= nad_ && gw_ < P0_CONV_ITEMS) convert_weights(F, args, 0, 3, gw_, F.G * NWAVES, 0, P0_CONV_ITEMS); } } SEAM(0);
#else
    if (IN(0)) { PH_ENTER(); p0_prologue(F, args); } SEAM(0);
#endif
    if (IN(1)) for (int rep_ = 0; rep_ < 1 + ((REPMASK >> 10) & 1); ++rep_) { PH_ENTER(); p1_prologue(F, args); } SEAM(1);
    for (int l = 0; l < DEPTH; ++l) {
        if (IN(PH_L(l, 0))) {
            PH_ENTER();
            const float* mod_l = (const float*)(F.ctl + CW_MOD) + (size_t)l * NB * 6 * D;
            if (l == 0) { norm_rows(F, opq(args.x), mod_l, 0, (bf16_t*)(F.ws + WS_HB)); if ((REPMASK >> 11) & 1) { for (int q_ = 0; q_ < 4; ++q_) norm_rows(F, opq(args.x), mod_l, 0, (bf16_t*)(F.ws + WS_HB)); } }
#if defined(SLACK_CONV) && SLACK_CONV
            else { convert_weights(F, args, l, moe_deal_t(F, l - 1) > 0 ? 2 : 3);
                   combine_phase<false>(F, opq(args.out), mod_l - (size_t)NB * 6 * D + 5 * D, mod_l); }
#else
            else { convert_weights(F, args, l, 3); combine_phase<false>(F, opq(args.out), mod_l - (size_t)NB * 6 * D + 5 * D, mod_l); }
#endif
        } SEAM(PH_L(l, 0));
        if (IN(PH_L(l, 1))) for (int rep_ = 0; rep_ < 1 + ((REPMASK >> 1) & 1); ++rep_) {
            if ((REPMASK >> 3) & 1) { PH_ENTER(); hgrn_scan_phase(F); __syncthreads(); }
            PH_ENTER(); unsigned char* ws = F.ws;
#if defined(G1_STAG) && G1_STAG
            { const int cls_ = ((int)(blockIdx.x >> 3) & 7) % 3; for (int i_ = 0; i_ < cls_ * G1_STAG; ++i_) __builtin_amdgcn_s_sleep(64); }
#endif
            DenseOrder So; So.init(ws + WS_HB, ws + WS_WIN, T, INC - 512, D, F.G, opqs((int)blockIdx.x));
            EpiProj E{(bf16_t*)(ws + WS_QA), (bf16_t*)(ws + WS_KA), (bf16_t*)(ws + WS_VA), (bf16_t*)(ws + WS_QH), (bf16_t*)(ws + WS_IH), (bf16_t*)(ws + WS_OG), (float*)(ws + WS_GH),
                      (const float*)(ws + WS_ROPE_C), (const float*)(ws + WS_ROPE_S), opq(args.lb_params), l, wt_make(ws)};
            gemm_phase<EpiProj, DenseOrder, false>(F.lds + RING_OFF, D, So, E, F.tid);
        } SEAM(PH_L(l, 1));
        if (IN(PH_L(l, 2))) for (int rep_ = 0; rep_ < 1 + ((REPMASK >> 2) & 1); ++rep_) { PH_ENTER(); hgrn_local_phase(F); } SEAM(PH_L(l, 2));
        if (IN(PH_L(l, 3))) {
            PH_ENTER(); hgrn_scan_phase(F);
            { PH_ENTER(); unsigned char* ws = F.ws;
              DenseOrder So; So.init(ws + WS_HB, ws + WS_WIN, T, 512, D, F.G / 2, opqs((int)blockIdx.x), 12);
              if ((int)blockIdx.x >= F.G / 2) So.nwg = 0;
              EpiProj E{(bf16_t*)(ws + WS_QA), (bf16_t*)(ws + WS_KA), (bf16_t*)(ws + WS_VA), (bf16_t*)(ws + WS_QH), (bf16_t*)(ws + WS_IH), (bf16_t*)(ws + WS_OG), (float*)(ws + WS_GH),
                        (const float*)(ws + WS_ROPE_C), (const float*)(ws + WS_ROPE_S), opq(args.lb_params), l, wt_make(ws)};
              gemm_phase<EpiProj, DenseOrder, false>(F.lds + RING_OFF, D, So, E, F.tid); }
        } SEAM(PH_L(l, 3));
        if (IN(PH_L(l, 4))) for (int rep_ = 0; rep_ < 1 + ((REPMASK >> 4) & 1); ++rep_) { PH_ENTER(); if (!((REPMASK >> 12) & 1) || rep_ == 0) hgrn_out_phase(F); __syncthreads(); if (!((REPMASK >> 13) & 1) || rep_ == 0) attn_phase(F); } SEAM(PH_L(l, 4));
        if (IN(PH_L(l, 5))) for (int rep_ = 0; rep_ < 1 + ((REPMASK >> 5) & 1); ++rep_) { PH_ENTER(); merge_phase(F, opq(args.attn_norm) + l * AW, opq(args.hgrn_norm) + l * HW); } SEAM(PH_L(l, 5));
        if (IN(PH_L(l, 6))) for (int rep_ = 0; rep_ < 1 + (((REPMASK >> 6) & 1) && l == 0 ? 1 : 0); ++rep_) {
            PH_ENTER(); unsigned char* ws = F.ws;
            DenseOrder So; So.init(ws + WS_HB, ws + WS_WOUT, T, D, D, F.G, opqs((int)blockIdx.x));
#if defined(EPI_HOIST) && (EPI_HOIST & 1)
            if (l == 0) { EpiOut<true> E{opq(args.x), (const bf16_t*)(ws + WS_XB), (bf16_t*)(ws + WS_XB), (const float*)(F.ctl + CW_MOD) + (size_t)l * NB * 6 * D + 2 * D, true, wt_make(ws)};
                gemm_phase<EpiOut<true>, DenseOrder, false>(F.lds + RING_OFF, D, So, E, F.tid); }
            else { EpiOut<false> E{opq(args.x), (const bf16_t*)(ws + WS_XB), (bf16_t*)(ws + WS_XB), (const float*)(F.ctl + CW_MOD) + (size_t)l * NB * 6 * D + 2 * D, false, wt_make(ws)};
                gemm_phase<EpiOut<false>, DenseOrder, false>(F.lds + RING_OFF, D, So, E, F.tid); }
#else
            EpiOut E{opq(args.x), (const bf16_t*)(ws + WS_XB), (bf16_t*)(ws + WS_XB), (const float*)(F.ctl + CW_MOD) + (size_t)l * NB * 6 * D + 2 * D, l == 0, wt_make(ws)};
            gemm_phase<EpiOut, DenseOrder, false>(F.lds + RING_OFF, D, So, E, F.tid);
#endif
        } SEAM(PH_L(l, 6));
        if (IN(PH_L(l, 7))) for (int rep_ = 0; rep_ < 1 + ((REPMASK >> 7) & 1); ++rep_) { PH_ENTER(); router_phase(F, (const bf16_t*)(F.ws + WS_XB), (const float*)(F.ctl + CW_MOD) + (size_t)l * NB * 6 * D, opq(args.w_router), opq(args.b_router), l, rep_ == 1); } SEAM(PH_L(l, 7));
#if !(defined(RT_ATOMIC) && RT_ATOMIC)
        if (IN(PH_L(l, 8))) { PH_ENTER(); scatter_phase(F, l); } SEAM(PH_L(l, 8));
#endif
        if (IN(PH_L(l, 9))) {
            { PH_ENTER(); unsigned char* ws = F.ws;
              MoeOrder<0> So{(const char*)(ws + WS_HB), (const char*)(ws + WS_WGU), (const unsigned*)(F.ctl + CW_CNT + l * 1024), (const int*)(ws + WS_LIST), D, F.G, opqs((int)blockIdx.x), (size_t)1024 * D * 2,
                          (unsigned*)(F.ctl + CW_RDY + l * 16384), (unsigned*)(F.ctl + CW_TMO)};
              So.load_counts();
              EpiGateUp E{(bf16_t*)(ws + WS_MH), (unsigned*)(F.ctl + CW_RDY + l * 16384), wt_make(ws)};
              gemm_phase<EpiGateUp, MoeOrder<0>, true>(F.lds + RING_OFF, D, So, E, F.tid); }
            { PH_ENTER(); unsigned char* ws = F.ws;
              MoeOrder<1> So{(const char*)(ws + WS_MH), (const char*)(ws + WS_WD), (const unsigned*)(F.ctl + CW_CNT + l * 1024), (const int*)(ws + WS_LIST), FF, F.G, opqs((int)blockIdx.x), (size_t)D * FF * 2,
                          (unsigned*)(F.ctl + CW_RDY + l * 16384), (unsigned*)(F.ctl + CW_TMO)};
              So.load_counts();
              EpiDown E{(bf16_t*)(ws + WS_Y), (const int*)(ws + WS_LIST), (const float*)(ws + WS_PW), wt_make(ws)};
              gemm_phase<EpiDown, MoeOrder<1>, false>(F.lds + RING_OFF, FF, So, E, F.tid); }
#if defined(SLACK_CONV) && SLACK_CONV
            if (l + 1 < DEPTH) {
                PH_ENTER(); const int t_ = moe_deal_t(F, l); const int c_ = opqs((int)blockIdx.x);
                if (t_ > 0 && c_ >= 3 * t_) convert_weights(F, args, l + 1, 1, (c_ - 3 * t_) * NWAVES + F.wave, (F.G - 3 * t_) * NWAVES);
            }
#endif
        } SEAM(PH_L(l, 9));
    }
    if (IN(NPH - 1)) { PH_ENTER(); combine_phase<true>(F, opq(args.out), (const float*)(F.ctl + CW_MOD) + (size_t)(DEPTH - 1) * NB * 6 * D + 5 * D, opq(args.final_norm)); }
#undef IN
#undef SEAM
#undef PH_ENTER
}
}
#ifndef MK_ONE_LAUNCH
#define MK_ONE_LAUNCH 0
#endif
extern "C" void kernel_launch(void* const* d_in, const int* in_sizes, int n_in, void* d_out, int out_size, void* d_ws, size_t ws_size, hipStream_t stream) {
    static int grid = 0;
    if (grid == 0) {
        int dev = 0, cus = 0; (void)hipGetDevice(&dev); (void)hipDeviceGetAttribute(&cus, hipDeviceAttributeMultiprocessorCount, dev);
        if (n_in != 16 || out_size != mk::T * mk::D || ws_size < mk::WS_END) { fprintf(stderr, "kernel_launch: unexpected problem (n_in %d, out %d, ws %zu)\n", n_in, out_size, ws_size); grid = -1; return; }
        if (hipFuncSetAttribute((const void*)mk::mk_fwd, hipFuncAttributeMaxDynamicSharedMemorySize, mk::LDS_BYTES) != hipSuccess) { fprintf(stderr, "hipFuncSetAttribute failed\n"); grid = -1; return; }
        grid = cus > 0 ? cus : 256;
    }
    if (grid < 0) return;
    mk::Args a{};
    a.x = (const float*)d_in[0]; a.c = (const float*)d_in[1]; a.positions = (const int*)d_in[2]; a.w_in = (const float*)d_in[3]; a.w_out = (const float*)d_in[4]; a.attn_norm = (const float*)d_in[5];
    a.hgrn_norm = (const float*)d_in[6]; a.lb_params = (const float*)d_in[7]; a.ada_w = (const float*)d_in[8]; a.ada_b = (const float*)d_in[9]; a.w_router = (const float*)d_in[10]; a.b_router = (const float*)d_in[11];
    a.w_gate = (const float*)d_in[12]; a.w_up = (const float*)d_in[13]; a.w_down = (const float*)d_in[14]; a.final_norm = (const float*)d_in[15]; a.out = (float*)d_out; a.ws = (unsigned char*)d_ws;
    (void)hipMemsetAsync((char*)d_ws + mk::WS_CTL, 0, mk::CTL_BYTES, stream);
#if MK_ONE_LAUNCH
    a.ph_lo = 0; a.ph_hi = mk::NPH;
    hipLaunchKernelGGL(mk::mk_fwd, dim3(grid), dim3(mk::NTHR), mk::LDS_BYTES, stream, a);
#else
    for (int p = 0; p < mk::NPH; ++p) { a.ph_lo = p; a.ph_hi = p + 1; hipLaunchKernelGGL(mk::mk_fwd, dim3(grid), dim3(mk::NTHR), mk::LDS_BYTES, stream, a); }
#endif
}
```
